# Optimizing an MI355X kernel written in HIP

```python
import math
import jax, jax.numpy as jnp
from jax import lax
import numpy as np

D_MODEL = 4096
BATCH = 4
SEQ = 4096
DEPTH = 2

GRID_W = 64
HEAD_DIM = 128
ROPE_THETA = 10000.0
Q_BLOCK = 128
LN_EPS = 1e-5
RMS_EPS = 1e-6

NA_HEADS = 8
NA_WIN_ROWS = 8
NA_WIN_COLS = 16
WIDTH_A = NA_HEADS * HEAD_DIM

MLA_HEADS = 8
MLA_Q_RANK = 1536
MLA_KV_RANK = 512
MLA_NOPE = 128
MLA_ROPE = 64
MLA_V = 128
WIDTH_B = MLA_HEADS * MLA_V

DIFF_HEADS = 8
DIFF_QK = 64
DIFF_V = 2 * DIFF_QK
WIDTH_C = DIFF_HEADS * DIFF_V

N_BRANCH = 3
DEEPNORM_ALPHA = (2.0 * DEPTH) ** 0.25
DEEPNORM_BETA = (8.0 * DEPTH) ** -0.25

IN_SPLITS = (
    WIDTH_A, WIDTH_A, WIDTH_A, WIDTH_A,
    MLA_Q_RANK, MLA_KV_RANK, MLA_ROPE, WIDTH_B,
    DIFF_HEADS * 2 * DIFF_QK, DIFF_HEADS * 2 * DIFF_QK, WIDTH_C, WIDTH_C,
    N_BRANCH * D_MODEL,
)
IN_WIDTH = sum(IN_SPLITS)

kernel_name = "hybrid_natten_mla_diffattn_encoder"


def _layer_norm(x, g, b):
    xf = x.astype(jnp.float32)
    mu = jnp.mean(xf, axis=-1, keepdims=True)
    var = jnp.mean(jnp.square(xf - mu), axis=-1, keepdims=True)
    return ((xf - mu) * lax.rsqrt(var + LN_EPS) * g + b).astype(x.dtype)


def _rms_norm(x, g):
    xf = x.astype(jnp.float32)
    return (xf * lax.rsqrt(jnp.mean(xf * xf, axis=-1, keepdims=True) + RMS_EPS) * g).astype(x.dtype)


def _rope(x, pos):
    d = x.shape[-1]
    half = d // 2
    inv_freq = ROPE_THETA ** (-jnp.arange(half, dtype=jnp.float32) * 2.0 / d)
    ang = pos.astype(jnp.float32)[:, None] * inv_freq[None, :]
    cos = jnp.cos(ang)[None, :, None, :]
    sin = jnp.sin(ang)[None, :, None, :]
    x1 = x[..., :half].astype(jnp.float32)
    x2 = x[..., half:].astype(jnp.float32)
    return jnp.concatenate([x1 * cos - x2 * sin, x2 * cos + x1 * sin], axis=-1).astype(x.dtype)


def _split_cols(h):
    points = np.cumsum(np.array(IN_SPLITS))[:-1].tolist()
    return jnp.split(h, points, axis=-1)


def _to_blocks(t):
    b, s = t.shape[0], t.shape[1]
    t = t.reshape((b, s // Q_BLOCK, Q_BLOCK) + t.shape[2:])
    return jnp.moveaxis(t, 1, 0)


def _from_blocks(t):
    t = jnp.moveaxis(t, 0, 1)
    return t.reshape((t.shape[0], t.shape[1] * t.shape[2]) + t.shape[3:])


def _dense_attention(q, k, v, scale):
    def one_block(qb):
        sc = jnp.einsum('bqhd,bkhd->bhqk', qb, k, preferred_element_type=jnp.float32) * scale
        p = jax.nn.softmax(sc, axis=-1)
        return jnp.einsum('bhqk,bkhd->bqhd', p.astype(v.dtype), v)
    return _from_blocks(lax.map(one_block, _to_blocks(q)))


def _diff_attention(q1, k1, q2, k2, v, lam, scale):
    def one_block(qs):
        q1b, q2b = qs
        p1 = jax.nn.softmax(jnp.einsum('bqhd,bkhd->bhqk', q1b, k1, preferred_element_type=jnp.float32) * scale, axis=-1)
        p2 = jax.nn.softmax(jnp.einsum('bqhd,bkhd->bhqk', q2b, k2, preferred_element_type=jnp.float32) * scale, axis=-1)
        p = (p1 - lam * p2).astype(v.dtype)
        return jnp.einsum('bhqk,bkhd->bqhd', p, v)
    return _from_blocks(lax.map(one_block, (_to_blocks(q1), _to_blocks(q2))))


def _neighbourhood_attention(q, k, v, rpb):
    b, s, h, d = q.shape
    rows = s // GRID_W
    kh = min(NA_WIN_ROWS, rows)
    kw = NA_WIN_COLS
    qg = q.reshape(b, rows, GRID_W, h, d)
    kg = k.reshape(b, rows, GRID_W, h, d)
    vg = v.reshape(b, rows, GRID_W, h, d)
    r = jnp.arange(rows)
    row_start = jnp.clip(r - kh // 2, 0, rows - kh)
    row_idx = row_start[:, None] + jnp.arange(kh)[None, :]
    k_rows = kg[:, row_idx]
    v_rows = vg[:, row_idx]
    c = jnp.arange(GRID_W)
    col_start = jnp.clip(c - kw // 2, 0, GRID_W - kw)
    col_in = (c[None, :] >= col_start[:, None]) & (c[None, :] < col_start[:, None] + kw)
    dr = row_idx - r[:, None] + (NA_WIN_ROWS - 1)
    dc = jnp.clip(c[None, :] - c[:, None] + (kw - 1), 0, 2 * kw - 2)
    bias = rpb[:, dr[:, None, :, None], dc[None, :, None, :]]
    sc = jnp.einsum('brqhd,brikhd->bhrqik', qg, k_rows, preferred_element_type=jnp.float32) * (d ** -0.5)
    sc = sc + bias[None].astype(jnp.float32)
    sc = jnp.where(col_in[:, None, :], sc, -jnp.inf)
    p = jax.nn.softmax(sc.reshape(b, h, rows, GRID_W, kh * GRID_W), axis=-1)
    p = p.reshape(b, h, rows, GRID_W, kh, GRID_W).astype(v.dtype)
    out = jnp.einsum('bhrqik,brikhd->brqhd', p, v_rows)
    return out.reshape(b, s, h, d)


def _hybrid_layer(x, layer_idx, w_in, w_uq, q_norm, w_ukv, kv_norm, na_rpb,
                  lam_q1, lam_k1, lam_q2, lam_k2, diff_subln,
                  w_o_a, w_o_b, w_o_c, b_merge, w_out, ln_g, ln_b):
    b, s, _ = x.shape
    pos = jnp.arange(s)
    h = jnp.einsum('bsd,dn->bsn', x, w_in)
    (a_q, a_k, a_v, a_gate,
     b_cq, b_ckv, b_krope, b_gate,
     c_q, c_k, c_v, c_gate,
     merge_logits) = _split_cols(h)

    ya = _neighbourhood_attention(a_q.reshape(b, s, NA_HEADS, HEAD_DIM),
                                  a_k.reshape(b, s, NA_HEADS, HEAD_DIM),
                                  a_v.reshape(b, s, NA_HEADS, HEAD_DIM), na_rpb)
    ya = ya.reshape(b, s, WIDTH_A) * jax.nn.silu(a_gate)

    cq = _rms_norm(b_cq, q_norm)
    qb = jnp.einsum('bsr,rn->bsn', cq, w_uq).reshape(b, s, MLA_HEADS, MLA_NOPE + MLA_ROPE)
    qb = jnp.concatenate([qb[..., :MLA_NOPE], _rope(qb[..., MLA_NOPE:], pos)], axis=-1)
    ckv = _rms_norm(b_ckv, kv_norm)
    kv = jnp.einsum('bsr,rn->bsn', ckv, w_ukv).reshape(b, s, MLA_HEADS, MLA_NOPE + MLA_V)
    k_nope, vb = kv[..., :MLA_NOPE], kv[..., MLA_NOPE:]
    k_rope = _rope(b_krope.reshape(b, s, 1, MLA_ROPE), pos)
    kb = jnp.concatenate([k_nope, jnp.broadcast_to(k_rope, (b, s, MLA_HEADS, MLA_ROPE))], axis=-1)
    yb = _dense_attention(qb, kb, vb, (MLA_NOPE + MLA_ROPE) ** -0.5)
    yb = yb.reshape(b, s, WIDTH_B) * jax.nn.silu(b_gate)

    qc = _rope(c_q.reshape(b, s, DIFF_HEADS * 2, DIFF_QK), pos).reshape(b, s, DIFF_HEADS, 2, DIFF_QK)
    kc = _rope(c_k.reshape(b, s, DIFF_HEADS * 2, DIFF_QK), pos).reshape(b, s, DIFF_HEADS, 2, DIFF_QK)
    vc = c_v.reshape(b, s, DIFF_HEADS, DIFF_V)
    lam_init = 0.8 - 0.6 * math.exp(-0.3 * layer_idx)
    lam = (jnp.exp(jnp.sum(lam_q1.astype(jnp.float32) * lam_k1.astype(jnp.float32)))
           - jnp.exp(jnp.sum(lam_q2.astype(jnp.float32) * lam_k2.astype(jnp.float32))) + lam_init)
    yc = _diff_attention(qc[:, :, :, 0], kc[:, :, :, 0], qc[:, :, :, 1], kc[:, :, :, 1], vc, lam, DIFF_QK ** -0.5)
    yc = _rms_norm(yc, diff_subln) * (1.0 - lam_init)
    yc = yc.reshape(b, s, WIDTH_C) * jax.nn.silu(c_gate)

    g = jax.nn.sigmoid(merge_logits + b_merge).reshape(b, s, N_BRANCH, D_MODEL)
    merged = (g[:, :, 0] * jnp.einsum('bsw,wd->bsd', ya, w_o_a)
              + g[:, :, 1] * jnp.einsum('bsw,wd->bsd', yb, w_o_b)
              + g[:, :, 2] * jnp.einsum('bsw,wd->bsd', yc, w_o_c))
    y = jnp.einsum('bsd,de->bse', merged, w_out)

    return _layer_norm(DEEPNORM_ALPHA * x + y, ln_g, ln_b)


def setup_inputs(seed: int = 0) -> dict:
    key = jax.random.key(seed)
    ks = jax.random.split(key, 20)
    f32 = jnp.float32

    def nrm(k, shape, scale):
        return jax.random.normal(k, shape, f32) * scale

    return {
        "x": nrm(ks[0], (BATCH, SEQ, D_MODEL), 1.0),
        "w_in": nrm(ks[1], (DEPTH, D_MODEL, IN_WIDTH), D_MODEL ** -0.5),
        "w_uq": nrm(ks[2], (DEPTH, MLA_Q_RANK, MLA_HEADS * (MLA_NOPE + MLA_ROPE)), MLA_Q_RANK ** -0.5),
        "q_norm": 1.0 + nrm(ks[3], (DEPTH, MLA_Q_RANK), 0.02),
        "w_ukv": nrm(ks[4], (DEPTH, MLA_KV_RANK, MLA_HEADS * (MLA_NOPE + MLA_V)), MLA_KV_RANK ** -0.5),
        "kv_norm": 1.0 + nrm(ks[5], (DEPTH, MLA_KV_RANK), 0.02),
        "na_rpb": nrm(ks[6], (DEPTH, NA_HEADS, 2 * NA_WIN_ROWS - 1, 2 * NA_WIN_COLS - 1), 0.05),
        "lam_q1": nrm(ks[7], (DEPTH, DIFF_QK), 0.1),
        "lam_k1": nrm(ks[8], (DEPTH, DIFF_QK), 0.1),
        "lam_q2": nrm(ks[9], (DEPTH, DIFF_QK), 0.1),
        "lam_k2": nrm(ks[10], (DEPTH, DIFF_QK), 0.1),
        "diff_subln": 1.0 + nrm(ks[11], (DEPTH, DIFF_V), 0.02),
        "w_o_a": nrm(ks[12], (DEPTH, WIDTH_A, D_MODEL), WIDTH_A ** -0.5 * DEEPNORM_BETA),
        "w_o_b": nrm(ks[13], (DEPTH, WIDTH_B, D_MODEL), WIDTH_B ** -0.5 * DEEPNORM_BETA),
        "w_o_c": nrm(ks[14], (DEPTH, WIDTH_C, D_MODEL), WIDTH_C ** -0.5 * DEEPNORM_BETA),
        "b_merge": nrm(ks[15], (DEPTH, N_BRANCH * D_MODEL), 0.02),
        "w_out": nrm(ks[16], (DEPTH, D_MODEL, D_MODEL), D_MODEL ** -0.5 * DEEPNORM_BETA),
        "ln_g": 1.0 + nrm(ks[17], (DEPTH, D_MODEL), 0.02),
        "ln_b": nrm(ks[18], (DEPTH, D_MODEL), 0.02),
    }


def reference(x, w_in, w_uq, q_norm, w_ukv, kv_norm, na_rpb, lam_q1, lam_k1, lam_q2, lam_k2,
              diff_subln, w_o_a, w_o_b, w_o_c, b_merge, w_out, ln_g, ln_b):
    for l in range(DEPTH):
        x = _hybrid_layer(x, l, w_in[l], w_uq[l], q_norm[l], w_ukv[l], kv_norm[l], na_rpb[l],
                          lam_q1[l], lam_k1[l], lam_q2[l], lam_k2[l], diff_subln[l],
                          w_o_a[l], w_o_b[l], w_o_c[l], b_merge[l], w_out[l], ln_g[l], ln_b[l])
    return x
```

```cpp
#include <hip/hip_runtime.h>
#include <cstdio>
#include <cstdint>
#ifndef MK_ONE_LAUNCH
#define MK_ONE_LAUNCH 1
#endif
namespace pg8 {
#define PG8_LAS __attribute__((address_space(3)))
typedef unsigned short bf16_t;
typedef short bf16x8 __attribute__((ext_vector_type(8)));
typedef float f32x4 __attribute__((ext_vector_type(4)));
typedef unsigned u32x4 __attribute__((ext_vector_type(4)));
constexpr int BM = 256, BK = 64, HALF = 128, HTB = HALF * BK * 2  , STAGE_BYTES = 8 * HTB, NXCD = 8, WGM = 8;

__host__ __device__ __forceinline__ int lds_byte(int r, int c) { const int st = (r >> 4) * 2 + (c >> 5), rr = r & 15, cc = c & 31, ob = rr * 64 + cc * 2; return st * 1024 + (ob ^ (((ob >> 9) & 1) << 5)); }
__host__ __device__ __forceinline__ void stage_rc(int b, int& R, int& C) { const int st = b / 1024, sb = b % 1024, swz = sb ^ (((sb >> 9) & 1) << 5); R = (st >> 1) * 16 + swz / 64; C = (st & 1) * 32 + (swz % 64) / 2; }
__host__ __device__ __forceinline__ int perm32(int rho) { const int n = rho >> 4, i = rho & 15; return 8 * (i >> 2) + 4 * n + (i & 3); }

struct Unit { int pm, pn; };
struct Gemm { const bf16_t* A; const bf16_t* Bt; int M, N, K; };

struct StaticOrder {
    int nM, nN, nwg, G, c;
    __host__ __device__ void init(int M, int N, int G_, int c_) { nM = M / BM; nN = N / BM; nwg = nM * nN; G = G_; c = c_; }
    __host__ __device__ bool next(int i, Unit& u) const {
        const long L = (long)i * G + c; if (L >= nwg) return false;
        int wgid = (int)L; { const int q = nwg / NXCD, r = nwg % NXCD, xcd = wgid % NXCD, off = wgid / NXCD; wgid = (xcd < r ? xcd * (q + 1) : r * (q + 1) + (xcd - r) * q) + off; }
        const int nig = WGM * nN, gid = wgid / nig, fm = gid * WGM, gsz = (nM - fm) < WGM ? (nM - fm) : WGM;
        u.pm = fm + ((wgid % nig) % gsz); u.pn = (wgid % nig) / gsz; return true;
    }
    __device__ __forceinline__ void a_ready(const Unit&) const {}
    __device__ __forceinline__ void done(const Unit&) const {}
};

__device__ __forceinline__ unsigned cvt_pk_bf16(float lo, float hi) { unsigned r; asm volatile("v_cvt_pk_bf16_f32 %0, %1, %2" : "=v"(r) : "v"(lo), "v"(hi)); return r; }
typedef float f32x2 __attribute__((ext_vector_type(2)));
__device__ __forceinline__ f32x2 gelu_pk(f32x2 v) {
    const f32x2 av = __builtin_elementwise_abs(v), d = av * 0.2316418882f + 1.0f;
    f32x2 t; t.x = __builtin_amdgcn_rcpf(d.x); t.y = __builtin_amdgcn_rcpf(d.y);
    f32x2 q = t * 0.5307027145f + (-0.7265760135f); q = q * t + 0.7107068705f; q = q * t + (-0.142248368f); q = q * t + 0.127414796f; q = q * t;
    const f32x2 s = (v * v) * (-0.72134752044f);
    f32x2 e; e.x = __builtin_amdgcn_exp2f(s.x); e.y = __builtin_amdgcn_exp2f(s.y);
    const f32x2 m = v * (q * e), r = v - m;
    f32x2 o; o.x = v.x < 0.f ? m.x : r.x; o.y = v.y < 0.f ? m.y : r.y; return o;
}

template <int ACT  > struct EpiBf16 {
    static constexpr bool PERM = true, AFTER_DRAIN = false; static_assert(ACT == 0 || ACT == 1, "EpiBf16: ACT is 0 (none) or 1 (gelu_pk)");
    bf16_t* O; int ldc; const float* bias; int split_cols; size_t split_stride; float scale0;
    __device__ __forceinline__ void operator()(const f32x4 (&acc)[2][2][4][2], const Unit& u, int wr, int wc, int fr, int fq) const {
        const int row0 = u.pm * BM + wr * 64 + fr; int colt = u.pn * BM; bf16_t* base = O;
        float sc = 1.f; if (split_cols) { const int t = colt / split_cols; base += (size_t)t * split_stride; colt -= t * split_cols; if (t == 0) sc = scale0; }
        const int col0 = colt + wc * 32 + 8 * fq, bcol0 = u.pn * BM + wc * 32 + 8 * fq;
        f32x4 bv[2][2];
#pragma unroll
        for (int bj = 0; bj < 2; ++bj)
#pragma unroll
            for (int n = 0; n < 2; ++n) bv[bj][n] = bias ? *(const f32x4*)(bias + bcol0 + bj * HALF + 4 * n) : (f32x4){0.f, 0.f, 0.f, 0.f};
#pragma unroll
        for (int ai = 0; ai < 2; ++ai)
#pragma unroll
            for (int m = 0; m < 4; ++m) { bf16_t* rowp = base + (size_t)(row0 + ai * HALF + m * 16) * ldc + col0;
#pragma unroll
                for (int bj = 0; bj < 2; ++bj) { f32x4 v0 = acc[ai][bj][m][0] + bv[bj][0], v1 = acc[ai][bj][m][1] + bv[bj][1];
                    if (ACT == 1) { f32x2 a = gelu_pk((f32x2){v0[0], v0[1]}), b = gelu_pk((f32x2){v0[2], v0[3]}), c = gelu_pk((f32x2){v1[0], v1[1]}), d = gelu_pk((f32x2){v1[2], v1[3]});
                        v0 = (f32x4){a.x, a.y, b.x, b.y}; v1 = (f32x4){c.x, c.y, d.x, d.y}; }
                    v0 = v0 * sc; v1 = v1 * sc; u32x4 w; w.x = cvt_pk_bf16(v0[0], v0[1]); w.y = cvt_pk_bf16(v0[2], v0[3]); w.z = cvt_pk_bf16(v1[0], v1[1]); w.w = cvt_pk_bf16(v1[2], v1[3]);
                    *(u32x4*)(rowp + bj * HALF) = w; } }
    }
};
typedef unsigned u32x2 __attribute__((ext_vector_type(2)));
__device__ __forceinline__ float sigm(float x) { return __builtin_amdgcn_rcpf(1.f + __builtin_amdgcn_exp2f(-1.4426950408889634f * x)); }
__device__ __forceinline__ f32x4 silu4(f32x4 v) { f32x4 o; o[0] = v[0] * sigm(v[0]); o[1] = v[1] * sigm(v[1]); o[2] = v[2] * sigm(v[2]); o[3] = v[3] * sigm(v[3]); return o; }
__device__ __forceinline__ f32x4 sigm4(f32x4 v) { f32x4 o; o[0] = sigm(v[0]); o[1] = sigm(v[1]); o[2] = sigm(v[2]); o[3] = sigm(v[3]); return o; }
__device__ __forceinline__ u32x4 pack8(f32x4 v0, f32x4 v1) { u32x4 w; w.x = cvt_pk_bf16(v0[0], v0[1]); w.y = cvt_pk_bf16(v0[2], v0[3]); w.z = cvt_pk_bf16(v1[0], v1[1]); w.w = cvt_pk_bf16(v1[2], v1[3]); return w; }
__device__ __forceinline__ u32x2 pack4(f32x4 v) { u32x2 w; w.x = cvt_pk_bf16(v[0], v[1]); w.y = cvt_pk_bf16(v[2], v[3]); return w; }
__device__ __forceinline__ f32x4 bf_lo4(u32x4 w) { f32x4 o; o[0] = __uint_as_float(w.x << 16); o[1] = __uint_as_float(w.x & 0xffff0000u); o[2] = __uint_as_float(w.y << 16); o[3] = __uint_as_float(w.y & 0xffff0000u); return o; }
__device__ __forceinline__ f32x4 bf_hi4(u32x4 w) { f32x4 o; o[0] = __uint_as_float(w.z << 16); o[1] = __uint_as_float(w.z & 0xffff0000u); o[2] = __uint_as_float(w.w << 16); o[3] = __uint_as_float(w.w & 0xffff0000u); return o; }
constexpr int TOK = 16384;
struct EpiH {
    static constexpr bool PERM = true, AFTER_DRAIN = false;
    bf16_t *AQKV, *AG, *CQB, *CKVB, *BG, *CQ, *CK, *CV, *CG, *GATE, *KB; float* part; const float* bmerge; const float* cosT; const float* sinT;
    __device__ __forceinline__ void operator()(const f32x4 (&acc)[2][2][4][2], const Unit& u, int wr, int wc, int fr, int fq) const {
        const int pn = u.pn; const int row0 = u.pm * BM + wr * 64 + fr;
        if (pn >= 28 && pn < 36) {
            bf16_t* dst = (pn < 32) ? CQ : CK; const int colt = ((pn - 28) & 3) * 256; const int i0 = 4 * (4 * (wc & 1) + fq);
#pragma unroll
            for (int ai = 0; ai < 2; ++ai)
#pragma unroll
                for (int m = 0; m < 4; ++m) { const int row = row0 + ai * HALF + m * 16; const int pos = row & 4095;
                    const f32x4 cs = *(const f32x4*)(cosT + pos * 32 + i0), sn = *(const f32x4*)(sinT + pos * 32 + i0);
#pragma unroll
                    for (int bj = 0; bj < 2; ++bj) { const f32x4 x1 = acc[ai][bj][m][0], x2 = acc[ai][bj][m][1]; const f32x4 o1 = x1 * cs - x2 * sn, o2 = x2 * cs + x1 * sn;
                        bf16_t* p = dst + (size_t)row * 1024 + colt + 64 * (2 * bj + (wc >> 1)) + i0; *(u32x2*)p = pack4(o1); *(u32x2*)(p + 32) = pack4(o2); } }
            return; }
        if (pn == 92) {
            if (wc < 2) { const int i0 = 4 * (4 * (wc & 1) + fq);
#pragma unroll
                for (int ai = 0; ai < 2; ++ai)
#pragma unroll
                    for (int m = 0; m < 4; ++m) { const int row = row0 + ai * HALF + m * 16; const int pos = row & 4095;
                        const f32x4 cs = *(const f32x4*)(cosT + pos * 32 + i0), sn = *(const f32x4*)(sinT + pos * 32 + i0);
                        const f32x4 x1 = acc[ai][0][m][0], x2 = acc[ai][0][m][1]; const u32x2 w1 = pack4(x1 * cs - x2 * sn), w2 = pack4(x2 * cs + x1 * sn);
                        bf16_t* p = KB + (size_t)row * 1536 + 128 + i0;
#pragma unroll
                        for (int h = 0; h < 8; ++h) { *(u32x2*)(p + h * 192) = w1; *(u32x2*)(p + h * 192 + 32) = w2; } } }
            return; }
        bf16_t* dst; int ldc, colt, mode;
        if (pn < 12)      { mode = 0; dst = AQKV + (size_t)(pn >> 2) * TOK * 1024; ldc = 1024; colt = (pn & 3) * 256; }
        else if (pn < 16) { mode = 1; dst = AG; ldc = 1024; colt = (pn - 12) * 256; }
        else if (pn < 22) { mode = 4; dst = CQB; ldc = 1536; colt = (pn - 16) * 256; }
        else if (pn < 24) { mode = 4; dst = CKVB; ldc = 512; colt = (pn - 22) * 256; }
        else if (pn < 28) { mode = 1; dst = BG; ldc = 1024; colt = (pn - 24) * 256; }
        else if (pn < 40) { mode = 0; dst = CV; ldc = 1024; colt = (pn - 36) * 256; }
        else if (pn < 44) { mode = 1; dst = CG; ldc = 1024; colt = (pn - 40) * 256; }
        else              { mode = 3; dst = GATE; ldc = 12288; colt = (pn - 44) * 256; }
        const int col0 = colt + wc * 32 + 8 * fq;
        f32x4 bv[2][2];
#pragma unroll
        for (int bj = 0; bj < 2; ++bj)
#pragma unroll
            for (int n = 0; n < 2; ++n) bv[bj][n] = (mode == 3) ? *(const f32x4*)(bmerge + col0 + bj * HALF + 4 * n) : (f32x4){0.f, 0.f, 0.f, 0.f};
#pragma unroll
        for (int ai = 0; ai < 2; ++ai)
#pragma unroll
            for (int m = 0; m < 4; ++m) { const int row = row0 + ai * HALF + m * 16; bf16_t* rowp = dst + (size_t)row * ldc + col0; float ss = 0.f;
#pragma unroll
                for (int bj = 0; bj < 2; ++bj) { f32x4 v0 = acc[ai][bj][m][0], v1 = acc[ai][bj][m][1];
                    if (mode == 1) { v0 = silu4(v0); v1 = silu4(v1); }
                    if (mode == 3) { v0 = sigm4(v0 + bv[bj][0]); v1 = sigm4(v1 + bv[bj][1]); }
                    if (mode == 4) { const f32x4 q0 = v0 * v0, q1 = v1 * v1; ss += ((q0[0] + q0[1]) + (q0[2] + q0[3])) + ((q1[0] + q1[1]) + (q1[2] + q1[3])); }
                    *(u32x4*)(rowp + bj * HALF) = pack8(v0, v1); }
                if (mode == 4) { ss += __shfl_xor(ss, 16); ss += __shfl_xor(ss, 32); if (fq == 0) part[(size_t)row * 32 + (pn - 16) * 4 + wc] = ss; } }
    }
};
struct EpiQ {
    static constexpr bool PERM = true, AFTER_DRAIN = false;
    bf16_t* QB; const float* part; const float* cosT; const float* sinT;
    __device__ __forceinline__ void operator()(const f32x4 (&acc)[2][2][4][2], const Unit& u, int wr, int wc, int fr, int fq) const {
        const int pn = u.pn; const int row0 = u.pm * BM + wr * 64 + fr; const int i0 = 4 * (4 * (wc & 1) + fq);
#pragma unroll
        for (int ai = 0; ai < 2; ++ai)
#pragma unroll
            for (int m = 0; m < 4; ++m) { const int row = row0 + ai * HALF + m * 16; const f32x4* pp = (const f32x4*)(part + (size_t)row * 32); float s = 0.f;
#pragma unroll
                for (int t = 0; t < 6; ++t) { const f32x4 q = pp[t]; s += (q[0] + q[1]) + (q[2] + q[3]); }
                const float rs = rsqrtf(s * (1.0f / 1536.0f) + 1e-6f);
                if (pn < 4) {
#pragma unroll
                    for (int bj = 0; bj < 2; ++bj) *(u32x4*)(QB + (size_t)row * 1536 + (2 * pn + bj) * 192 + wc * 32 + 8 * fq) = pack8(acc[ai][bj][m][0] * rs, acc[ai][bj][m][1] * rs);
                } else { const int pos = row & 4095; const f32x4 cs = *(const f32x4*)(cosT + pos * 32 + i0), sn = *(const f32x4*)(sinT + pos * 32 + i0);
#pragma unroll
                    for (int bj = 0; bj < 2; ++bj) { const f32x4 x1 = acc[ai][bj][m][0] * rs, x2 = acc[ai][bj][m][1] * rs; const int head = 4 * (pn - 4) + 2 * bj + (wc >> 1);
                        bf16_t* p = QB + (size_t)row * 1536 + head * 192 + 128 + i0; *(u32x2*)p = pack4(x1 * cs - x2 * sn); *(u32x2*)(p + 32) = pack4(x2 * cs + x1 * sn); } } }
    }
};
struct EpiKV {
    static constexpr bool PERM = true, AFTER_DRAIN = false;
    bf16_t* KB; bf16_t* VB; const float* part;
    __device__ __forceinline__ void operator()(const f32x4 (&acc)[2][2][4][2], const Unit& u, int wr, int wc, int fr, int fq) const {
        const int pn = u.pn; const int row0 = u.pm * BM + wr * 64 + fr;
#pragma unroll
        for (int ai = 0; ai < 2; ++ai)
#pragma unroll
            for (int m = 0; m < 4; ++m) { const int row = row0 + ai * HALF + m * 16; const f32x4* pp = (const f32x4*)(part + (size_t)row * 32 + 24); const f32x4 a = pp[0], b = pp[1];
                const float rs = rsqrtf((((a[0] + a[1]) + (a[2] + a[3])) + ((b[0] + b[1]) + (b[2] + b[3]))) * (1.0f / 512.0f) + 1e-6f);
                *(u32x4*)(KB + (size_t)row * 1536 + pn * 192 + wc * 32 + 8 * fq) = pack8(acc[ai][0][m][0] * rs, acc[ai][0][m][1] * rs);
                *(u32x4*)(VB + (size_t)row * 1024 + pn * 128 + wc * 32 + 8 * fq) = pack8(acc[ai][1][m][0] * rs, acc[ai][1][m][1] * rs); }
    }
};
struct EpiMerge {
    static constexpr bool PERM = true, AFTER_DRAIN = false;
    const bf16_t* GATE; float* MF; bf16_t* MBF;
    __device__ __forceinline__ void operator()(const f32x4 (&acc)[2][2][4][2], const Unit& u, int wr, int wc, int fr, int fq) const {
        const int seg = u.pm >> 6, pm = u.pm & 63, pn = u.pn & 15; const int row0 = pm * BM + wr * 64 + fr, col0 = pn * BM + wc * 32 + 8 * fq;
#pragma unroll
        for (int ai = 0; ai < 2; ++ai)
#pragma unroll
            for (int m = 0; m < 4; ++m) { const int row = row0 + ai * HALF + m * 16;
#pragma unroll
                for (int bj = 0; bj < 2; ++bj) { const int c = col0 + bj * HALF; const u32x4 g = *(const u32x4*)(GATE + (size_t)row * 12288 + seg * 4096 + c);
                    f32x4 v0 = acc[ai][bj][m][0] * bf_lo4(g), v1 = acc[ai][bj][m][1] * bf_hi4(g); float* mp = MF + (size_t)row * 4096 + c;
                    if (seg > 0) { v0 += *(const f32x4*)mp; v1 += *(const f32x4*)(mp + 4); }
                    if (seg < 2) { *(f32x4*)mp = v0; *(f32x4*)(mp + 4) = v1; } else *(u32x4*)(MBF + (size_t)row * 4096 + c) = pack8(v0, v1); } }
    }
};
struct EpiZ {
    static constexpr bool PERM = true, AFTER_DRAIN = false;
    const float* X; float* Z; float alpha;
    __device__ __forceinline__ void operator()(const f32x4 (&acc)[2][2][4][2], const Unit& u, int wr, int wc, int fr, int fq) const {
        const int row0 = u.pm * BM + wr * 64 + fr, col0 = u.pn * BM + wc * 32 + 8 * fq;
#pragma unroll
        for (int ai = 0; ai < 2; ++ai)
#pragma unroll
            for (int m = 0; m < 4; ++m) { const size_t ro = (size_t)(row0 + ai * HALF + m * 16) * 4096 + col0;
#pragma unroll
                for (int bj = 0; bj < 2; ++bj) { const float* xp = X + ro + bj * HALF; float* zp = Z + ro + bj * HALF;
                    *(f32x4*)zp = *(const f32x4*)xp * alpha + acc[ai][bj][m][0]; *(f32x4*)(zp + 4) = *(const f32x4*)(xp + 4) * alpha + acc[ai][bj][m][1]; } }
    }
};
struct MergeOrder {
    StaticOrder b;
    __device__ __forceinline__ bool next(int i, Unit& u) const { Unit t; if (!b.next(i / 3, t)) return false; const int seg = i % 3; u.pm = seg * 64 + t.pm; u.pn = seg * 16 + t.pn; return true; }
    __device__ __forceinline__ void a_ready(const Unit&) const {}
    __device__ __forceinline__ void done(const Unit&) const {}
};
struct ListOrder {
    int nN, first, stride, cnt;
    __device__ __forceinline__ bool next(int i, Unit& u) const { if (i >= cnt) return false; const int L = first + i * stride; u.pm = L / nN; u.pn = L % nN; return true; }
    __device__ __forceinline__ void a_ready(const Unit&) const {}
    __device__ __forceinline__ void done(const Unit&) const {}
};
template <class Epi, class Sched, bool ALIGN_EPI = false, bool SP2 = false>
__device__ __forceinline__ void gemm_phase(PG8_LAS unsigned char* lds, const Gemm g, const Sched& S, const Epi& E) {
    int tid_ = threadIdx.x; asm volatile("" : "+v"(tid_));
    const int tid = tid_, wid = __builtin_amdgcn_readfirstlane(tid >> 6), lane = tid & 63, wr = wid >> 2, wc = wid & 3, fr = lane & 15, fq = lane >> 4;
    const int K = g.K, nt = K / BK;
    unsigned voffA[2], voffB[2];
#pragma unroll
    for (int i = 0; i < 2; ++i) { int R, C; stage_rc(tid * 16 + i * 8192, R, C); const int Rb = Epi::PERM ? ((R & ~31) + perm32(R & 31)) : R;
        voffA[i] = (unsigned)(R * K + C) * 2u; voffB[i] = (unsigned)(Rb * K + C) * 2u; }
    const size_t kstep = (size_t)(BK * 2);
    const size_t hstep = (size_t)HALF * K * 2;
    const size_t tstep = 2 * hstep;
    const unsigned ldsw = (unsigned)wid * 1024u;
    const int aoff = lds_byte(wr * 64 + fr, fq * 8), boff = lds_byte(wc * 32 + fr, fq * 8);
#define PG8_SA(b, h) (((b) * 2 + (h)) * HTB)
#define PG8_SB(b, h) ((4 + (b) * 2 + (h)) * HTB)
#define PG8_STAGE(bufoff, gbase, voff) do { _Pragma("unroll") for (int _i = 0; _i < 2; ++_i) \
        __builtin_amdgcn_global_load_lds((const unsigned*)((const char*)(gbase) + (voff)[_i]), (PG8_LAS unsigned*)(lds + (bufoff) + ldsw + _i * 8192), 16, 0, 0); } while (0)
#define PG8_LDA(dst, b, h) do { _Pragma("unroll") for (int m = 0; m < 4; ++m) _Pragma("unroll") for (int k = 0; k < 2; ++k) dst[m][k] = *(const PG8_LAS bf16x8*)(lds + PG8_SA(b, h) + aoff + m * 2048 + k * 1024); } while (0)
#define PG8_LDB(dst, b, h) do { _Pragma("unroll") for (int n = 0; n < 2; ++n) _Pragma("unroll") for (int k = 0; k < 2; ++k) dst[n][k] = *(const PG8_LAS bf16x8*)(lds + PG8_SB(b, h) + boff + n * 2048 + k * 1024); } while (0)
#define PG8_MMA(ai, bj, At, Bt) do { __builtin_amdgcn_s_setprio(1); _Pragma("unroll") for (int m = 0; m < 4; ++m) _Pragma("unroll") for (int n = 0; n < 2; ++n) _Pragma("unroll") for (int k = 0; k < 2; ++k) \
        acc[ai][bj][m][n] = __builtin_amdgcn_mfma_f32_16x16x32_bf16(Bt[n][k], At[m][k], acc[ai][bj][m][n], 0, 0, 0); __builtin_amdgcn_s_setprio(0); } while (0)
#define PG8_WAIT_V(n) asm volatile("s_waitcnt vmcnt(" #n ")" ::: "memory")
#define PG8_WAIT_L(n) asm volatile("s_waitcnt lgkmcnt(" #n ")" ::: "memory")
#define PG8_BAR __builtin_amdgcn_s_barrier()
#define PG8_SCHED __builtin_amdgcn_sched_barrier(0)
    Unit cur, nxt; int ui = 0;
    if (!S.next(0, cur)) return;
    f32x4 acc[2][2][4][2];
#pragma unroll
    for (int a = 0; a < 2; ++a)
#pragma unroll
        for (int b = 0; b < 2; ++b)
#pragma unroll
            for (int m = 0; m < 4; ++m)
#pragma unroll
                for (int n = 0; n < 2; ++n) acc[a][b][m][n] = (f32x4){0.f, 0.f, 0.f, 0.f};
    bf16x8 At[4][2], B0[2][2], B1[2][2];
    const char* cA = (const char*)g.A + (size_t)cur.pm * tstep; const char* cB = (const char*)g.Bt + (size_t)cur.pn * tstep;
    S.a_ready(cur);
    if constexpr (SP2) {
        PG8_STAGE(PG8_SB(0, 0), cB, voffB); PG8_STAGE(PG8_SB(0, 1), cB + hstep, voffB); PG8_STAGE(PG8_SA(0, 0), cA, voffA); PG8_STAGE(PG8_SA(0, 1), cA + hstep, voffA);
        if (wr == 1) PG8_BAR;
        PG8_WAIT_V(2); PG8_BAR;
        PG8_STAGE(PG8_SB(1, 0), cB + kstep, voffB); PG8_STAGE(PG8_SA(1, 0), cA + kstep, voffA); PG8_STAGE(PG8_SB(1, 1), cB + hstep + kstep, voffB);
        PG8_WAIT_V(6); PG8_BAR;
    } else {
        PG8_STAGE(PG8_SB(0, 0), cB, voffB); PG8_STAGE(PG8_SA(0, 0), cA, voffA); PG8_STAGE(PG8_SB(0, 1), cB + hstep, voffB); PG8_STAGE(PG8_SA(0, 1), cA + hstep, voffA);
        if (wr == 1) PG8_BAR;
        PG8_WAIT_V(4); PG8_BAR;
        PG8_STAGE(PG8_SB(1, 0), cB + kstep, voffB); PG8_STAGE(PG8_SA(1, 0), cA + kstep, voffA); PG8_STAGE(PG8_SB(1, 1), cB + hstep + kstep, voffB);
        PG8_WAIT_V(6); PG8_BAR;
    }
    for (;;) {
        const bool has_next = S.next(ui + 1, nxt);
        const char* nA = has_next ? (const char*)g.A + (size_t)nxt.pm * tstep : cA; const char* nB = has_next ? (const char*)g.Bt + (size_t)nxt.pn * tstep : cB;
        for (int t = 0; t < nt; t += 2) {
            const bool last = (t == nt - 2);
            const char* a1 = cA + (size_t)(t + 1) * kstep;
            const char* a2 = last ? nA : cA + (size_t)(t + 2) * kstep; const char* b2 = last ? nB : cB + (size_t)(t + 2) * kstep;
            const char* a3 = a2 + kstep; const char* b3 = b2 + kstep;
            if (last && has_next) S.a_ready(nxt);
            if constexpr (SP2) {
            PG8_LDB(B0, 0, 0); PG8_LDB(B1, 0, 1); PG8_SCHED; PG8_LDA(At, 0, 0); PG8_STAGE(PG8_SA(1, 1), a1 + hstep, voffA);
            PG8_WAIT_V(8); PG8_WAIT_L(0); PG8_BAR; PG8_MMA(0, 0, At, B0); PG8_MMA(0, 1, At, B1); PG8_BAR; PG8_SCHED;
            PG8_LDA(At, 0, 1); PG8_STAGE(PG8_SB(0, 0), b2, voffB); PG8_STAGE(PG8_SB(0, 1), b2 + hstep, voffB); PG8_STAGE(PG8_SA(0, 0), a2, voffA);
            PG8_WAIT_V(8); PG8_WAIT_L(0); PG8_BAR; PG8_MMA(1, 0, At, B0); PG8_MMA(1, 1, At, B1); PG8_BAR; PG8_SCHED;
            PG8_LDB(B0, 1, 0); PG8_LDB(B1, 1, 1); PG8_SCHED; PG8_LDA(At, 1, 0); PG8_STAGE(PG8_SA(0, 1), a2 + hstep, voffA);
            PG8_WAIT_V(8); PG8_WAIT_L(0); PG8_BAR; PG8_MMA(0, 0, At, B0); PG8_MMA(0, 1, At, B1); PG8_BAR; PG8_SCHED;
            PG8_LDA(At, 1, 1); PG8_STAGE(PG8_SB(1, 0), b3, voffB); PG8_STAGE(PG8_SB(1, 1), b3 + hstep, voffB); PG8_STAGE(PG8_SA(1, 0), a3, voffA);
            PG8_WAIT_V(8); PG8_WAIT_L(0); PG8_BAR; PG8_MMA(1, 0, At, B0); PG8_MMA(1, 1, At, B1); PG8_BAR; PG8_SCHED;
            } else {
            PG8_LDB(B0, 0, 0); PG8_SCHED; PG8_LDA(At, 0, 0); PG8_STAGE(PG8_SA(1, 1), a1 + hstep, voffA);
            PG8_WAIT_L(8); PG8_BAR; PG8_WAIT_L(0); PG8_MMA(0, 0, At, B0); PG8_BAR; PG8_SCHED;
            PG8_LDB(B1, 0, 1); PG8_STAGE(PG8_SB(0, 0), b2, voffB);
            PG8_BAR; PG8_WAIT_L(0); PG8_MMA(0, 1, At, B1); PG8_BAR;
            PG8_LDA(At, 0, 1); PG8_STAGE(PG8_SA(0, 0), a2, voffA);
            PG8_BAR; PG8_WAIT_L(0); PG8_MMA(1, 0, At, B0); PG8_BAR; PG8_SCHED;
            PG8_STAGE(PG8_SB(0, 1), b2 + hstep, voffB);
            PG8_WAIT_V(6); PG8_BAR; PG8_MMA(1, 1, At, B1); PG8_BAR;
            PG8_LDB(B0, 1, 0); PG8_SCHED; PG8_LDA(At, 1, 0); PG8_STAGE(PG8_SA(0, 1), a2 + hstep, voffA);
            PG8_WAIT_L(8); PG8_BAR; PG8_WAIT_L(0); PG8_MMA(0, 0, At, B0); PG8_BAR; PG8_SCHED;
            PG8_LDB(B1, 1, 1); PG8_STAGE(PG8_SB(1, 0), b3, voffB);
            PG8_BAR; PG8_WAIT_L(0); PG8_MMA(0, 1, At, B1); PG8_BAR;
            PG8_LDA(At, 1, 1); PG8_STAGE(PG8_SA(1, 0), a3, voffA);
            PG8_BAR; PG8_WAIT_L(0); PG8_MMA(1, 0, At, B0); PG8_BAR; PG8_SCHED;
            PG8_STAGE(PG8_SB(1, 1), b3 + hstep, voffB);
            PG8_WAIT_V(6); PG8_BAR; PG8_MMA(1, 1, At, B1); PG8_BAR;
            }
        }
        if constexpr (ALIGN_EPI) { if (wr == 0) PG8_BAR; }
        if constexpr (!Epi::AFTER_DRAIN) { E(acc, cur, wr, wc, fr, fq); S.done(cur); }
        if (!has_next) break;
#pragma unroll
        for (int a = 0; a < 2; ++a)
#pragma unroll
            for (int b = 0; b < 2; ++b)
#pragma unroll
                for (int m = 0; m < 4; ++m)
#pragma unroll
                    for (int n = 0; n < 2; ++n) acc[a][b][m][n] = (f32x4){0.f, 0.f, 0.f, 0.f};
        cur = nxt; cA = nA; cB = nB; ++ui;
        if constexpr (ALIGN_EPI) { if (wr == 1) PG8_BAR; }
    }
    PG8_WAIT_V(0);
    if constexpr (!ALIGN_EPI) { if (wr == 0) PG8_BAR; }
    PG8_BAR;
    if constexpr (Epi::AFTER_DRAIN) { E.fused(acc, cur, wr, wc, fr, fq, lds, wid, lane); S.done(cur); }
#undef PG8_SA
#undef PG8_SB
#undef PG8_STAGE
#undef PG8_LDA
#undef PG8_LDB
#undef PG8_MMA
#undef PG8_WAIT_V
#undef PG8_WAIT_L
#undef PG8_BAR
#undef PG8_SCHED
}
}
namespace att {
#define ALAS __attribute__((address_space(3)))
typedef unsigned short bf16_t;
typedef short bf16x8 __attribute__((ext_vector_type(8)));
typedef short s16x4 __attribute__((ext_vector_type(4)));
typedef float f32x16 __attribute__((ext_vector_type(16)));
typedef unsigned u32x4 __attribute__((ext_vector_type(4)));
#define ASBAR() __builtin_amdgcn_sched_barrier(0)
__device__ __forceinline__ int crow(int r, int hi) { return (r & 3) + 8 * (r >> 2) + 4 * hi; }
__device__ __forceinline__ unsigned cvtpk(float lo, float hi) { unsigned r; asm volatile("v_cvt_pk_bf16_f32 %0, %1, %2" : "=v"(r) : "v"(lo), "v"(hi)); return r; }
struct PolNA   { static constexpr float SCALE = 0.08838834764831845f; };
struct PolMLA  { static constexpr float SCALE = 0.07216878364870323f; };
struct PolDiff { static constexpr float SCALE = 0.125f; };
constexpr float ATHR = 8.f;
template <class P> __device__ __forceinline__ void partialSM(f32x16& p0, f32x16& p1, float& m_reg, float& mn, float& alpha) {
  constexpr float C = P::SCALE * 1.4426950408889634f;
  float pmax = p0[0];
#pragma unroll
  for (int r = 1; r < 16; ++r) pmax = fmaxf(pmax, p0[r]);
#pragma unroll
  for (int r = 0; r < 16; ++r) pmax = fmaxf(pmax, p1[r]);
  { auto rr = __builtin_amdgcn_permlane32_swap(__float_as_uint(pmax), __float_as_uint(pmax), false, false);
    pmax = fmaxf(__uint_as_float(rr[0]), __uint_as_float(rr[1])); }
  if (__builtin_expect(__all(pmax - m_reg <= ATHR / P::SCALE), 1)) { mn = m_reg; alpha = 1.f; }
  else { mn = fmaxf(m_reg, pmax); alpha = __builtin_amdgcn_exp2f((m_reg - mn) * C); m_reg = mn; }
  const float mnC = -mn * C;
#pragma unroll
  for (int r = 0; r < 16; ++r) p0[r] = fmaf(p0[r], C, mnC);
#pragma unroll
  for (int r = 0; r < 16; ++r) p1[r] = fmaf(p1[r], C, mnC);
#pragma unroll
  for (int r = 0; r < 16; ++r) p0[r] = __builtin_amdgcn_exp2f(p0[r]);
}
__device__ __forceinline__ void finishSM(f32x16& p0, f32x16& p1, float alpha, float& l_reg, bf16x8& pa0, bf16x8& pa1, bf16x8& pa2, bf16x8& pa3) {
#pragma unroll
  for (int r = 0; r < 16; ++r) p1[r] = __builtin_amdgcn_exp2f(p1[r]);
  float ps = 0;
#pragma unroll
  for (int r = 0; r < 16; ++r) ps += p0[r];
#pragma unroll
  for (int r = 0; r < 16; ++r) ps += p1[r];
  { auto rr = __builtin_amdgcn_permlane32_swap(__float_as_uint(ps), __float_as_uint(ps), false, false);
    ps = __uint_as_float(rr[0]) + __uint_as_float(rr[1]); }
  l_reg = l_reg * alpha + ps;
#define APK4(P, BASE, OUT) do { unsigned a0 = cvtpk(P[BASE + 0], P[BASE + 1]), a1 = cvtpk(P[BASE + 2], P[BASE + 3]);   \
    unsigned b0 = cvtpk(P[BASE + 4], P[BASE + 5]), b1 = cvtpk(P[BASE + 6], P[BASE + 7]);                              \
    auto r0 = __builtin_amdgcn_permlane32_swap(a0, b0, false, false); auto r1 = __builtin_amdgcn_permlane32_swap(a1, b1, false, false); \
    u32x4 w = {r0[0], r1[0], r0[1], r1[1]}; OUT = __builtin_bit_cast(bf16x8, w); } while (0)
  APK4(p0, 0, pa0); APK4(p0, 8, pa1); APK4(p1, 0, pa2); APK4(p1, 8, pa3);
#undef APK4
}
template <int KW, int ND0, int NDL> __device__ __forceinline__ void qkt(f32x16& p0, f32x16& p1, const ALAS char* Ks, const bf16x8 (&qr)[ND0 > 0 ? ND0 : 1], const ALAS char* QL_, int r32, int hi, int kcb0) {
  p0 = f32x16{}; p1 = f32x16{}; const ALAS char* QL = QL_;
  const int swz = (r32 & 7) << 4; const ALAS char* k0 = Ks + r32 * (KW * 2); const ALAS char* k1 = Ks + (32 + r32) * (KW * 2);
#pragma unroll
  for (int d0 = 0; d0 < ND0; ++d0) { const int cb = (kcb0 + d0 * 32 + hi * 16) ^ swz;
    const bf16x8 b0 = *(const ALAS bf16x8*)(k0 + cb); const bf16x8 b1 = *(const ALAS bf16x8*)(k1 + cb);
    p0 = __builtin_amdgcn_mfma_f32_32x32x16_bf16(b0, qr[d0], p0, 0, 0, 0);
    p1 = __builtin_amdgcn_mfma_f32_32x32x16_bf16(b1, qr[d0], p1, 0, 0, 0); }
  if (NDL > 0) asm volatile("" : "+v"(QL));
#pragma unroll
  for (int d0 = ND0; d0 < ND0 + NDL; ++d0) { const int cb = (kcb0 + d0 * 32 + hi * 16) ^ swz;
    const bf16x8 b0 = *(const ALAS bf16x8*)(k0 + cb); const bf16x8 b1 = *(const ALAS bf16x8*)(k1 + cb); const bf16x8 q = *(const ALAS bf16x8*)(QL + (d0 - ND0) * 1024);
    p0 = __builtin_amdgcn_mfma_f32_32x32x16_bf16(b0, q, p0, 0, 0, 0);
    p1 = __builtin_amdgcn_mfma_f32_32x32x16_bf16(b1, q, p1, 0, 0, 0); }
}
__device__ __forceinline__ int v_st(int k, int c) { const int kk = (k & ~0xC) | ((k & 4) << 1) | ((k & 8) >> 1); return ((kk >> 3) * 4 + (c >> 5)) * 512 + ((kk & 7) * 32 + (c & 31)) * 2; }
__device__ __forceinline__ int v_rd_base(int lane) { return ((lane & 3) << 3) | (((lane >> 2) & 3) << 6) | (((lane >> 4) & 1) << 5) | (((lane >> 5) & 1) << 8); }
constexpr int v_rd_off(int d0, int ks, int half) { return d0 * 512 + ks * 4096 + half * 2048; }
template <int OFF> __device__ __forceinline__ s16x4 tr_read(int vb) { s16x4 r; asm volatile("ds_read_b64_tr_b16 %0, %1 offset:%2" : "=&v"(r) : "v"(vb), "i"(OFF) : "memory"); return r; }
template <int D0> __device__ __forceinline__ void pv_one(f32x16& od, int vb, bf16x8 pa0, bf16x8 pa1, bf16x8 pa2, bf16x8 pa3) {
  const s16x4 l0 = tr_read<v_rd_off(D0, 0, 0)>(vb), h0 = tr_read<v_rd_off(D0, 0, 1)>(vb), l1 = tr_read<v_rd_off(D0, 1, 0)>(vb), h1 = tr_read<v_rd_off(D0, 1, 1)>(vb);
  const s16x4 l2 = tr_read<v_rd_off(D0, 2, 0)>(vb), h2 = tr_read<v_rd_off(D0, 2, 1)>(vb), l3 = tr_read<v_rd_off(D0, 3, 0)>(vb), h3 = tr_read<v_rd_off(D0, 3, 1)>(vb);
  asm volatile("s_waitcnt lgkmcnt(0)" ::: "memory"); ASBAR();
#define APK(L, H) (bf16x8){L[0], L[1], L[2], L[3], H[0], H[1], H[2], H[3]}
  od = __builtin_amdgcn_mfma_f32_32x32x16_bf16(pa0, APK(l0, h0), od, 0, 0, 0);
  od = __builtin_amdgcn_mfma_f32_32x32x16_bf16(pa1, APK(l1, h1), od, 0, 0, 0);
  od = __builtin_amdgcn_mfma_f32_32x32x16_bf16(pa2, APK(l2, h2), od, 0, 0, 0);
  od = __builtin_amdgcn_mfma_f32_32x32x16_bf16(pa3, APK(l3, h3), od, 0, 0, 0);
#undef APK
}
__device__ __forceinline__ void pv_d0(f32x16 (&o)[4], int vb, bf16x8 pa0, bf16x8 pa1, bf16x8 pa2, bf16x8 pa3) {
  pv_one<0>(o[0], vb, pa0, pa1, pa2, pa3); pv_one<1>(o[1], vb, pa0, pa1, pa2, pa3); pv_one<2>(o[2], vb, pa0, pa1, pa2, pa3); pv_one<3>(o[3], vb, pa0, pa1, pa2, pa3);
}
struct NoHook { __device__ __forceinline__ void operator()(f32x16&, f32x16&, int) const {} };
template <int KW, int NDL> struct Geo { static constexpr int SHM_V = 16384, SHM_K = 64 * KW * 2, OFF_K = 2 * SHM_V, OFF_WS = OFF_K + 2 * SHM_K, OFF_Q = OFF_WS + 8 * 256, BYTES = OFF_Q + 8 * NDL * 1024; };
template <int KW, int ND0, int NDL, class P, class Hook>
__device__ __forceinline__ void attn_core(const bf16_t* __restrict__ Qw, const bf16_t* __restrict__ Kh, const bf16_t* __restrict__ Vh, const int ldk, const int ldv,
                                          const int kcb0, const int NT, ALAS char* lds, const Hook& hook, f32x16 (&o)[4]) {
  typedef Geo<KW, NDL> G; constexpr int KROWB = KW * 2, KCH = KW / 8, KPT = (64 * KCH) / 512;
  int tid_ = threadIdx.x; asm volatile("" : "+v"(tid_));
  const int tid = tid_, wid = tid >> 6, lane = tid & 63, r32 = lane & 31, hi = lane >> 5;
  ALAS char* V_lds = lds; ALAS char* K_lds = lds + G::OFF_K;
  ALAS float* wsf = (ALAS float*)(lds + G::OFF_WS) + wid * 64; ALAS float* li_l = wsf; ALAS float* al_l = wsf + 32;
  float m_reg = -1e30f, l_reg = 0.f;
#pragma unroll
  for (int d = 0; d < 4; ++d) o[d] = f32x16{};
  bf16x8 qr[ND0 > 0 ? ND0 : 1]; ALAS char* QL = lds + G::OFF_Q + (wid * NDL * 64 + lane) * 16;
#pragma unroll
  for (int d0 = 0; d0 < ND0; ++d0) qr[d0] = *(const bf16x8*)(Qw + d0 * 16);
#pragma unroll
  for (int d0 = 0; d0 < NDL; ++d0) *(ALAS bf16x8*)(QL + d0 * 1024) = *(const bf16x8*)(Qw + (ND0 + d0) * 16);
  const int sr = tid >> 4, sc = (tid & 15) * 8, vst0 = v_st(sr, sc), vst1 = v_st(32 + sr, sc);
  int kgo[KPT], klo[KPT];
#pragma unroll
  for (int i = 0; i < KPT; ++i) { const int id = tid + i * 512, row = id / KCH, ch = id % KCH; kgo[i] = row * ldk + ch * 8; klo[i] = row * KROWB + ((ch * 16) ^ ((row & 7) << 4)); }
  const int vb0 = (int)(unsigned)(size_t)V_lds + v_rd_base(lane);
  bf16x8 vs0, vs1, ks[KPT];
#define A_SLOAD(k0) do { vs0 = *(const bf16x8*)(Vh + (long)((k0) + sr) * ldv + sc); vs1 = *(const bf16x8*)(Vh + (long)((k0) + 32 + sr) * ldv + sc); \
    _Pragma("unroll") for (int _i = 0; _i < KPT; ++_i) ks[_i] = *(const bf16x8*)(Kh + (long)(k0) * ldk + kgo[_i]); } while (0)
#define A_SWRITE(b) do { *(ALAS bf16x8*)(V_lds + (b) * G::SHM_V + vst0) = vs0; *(ALAS bf16x8*)(V_lds + (b) * G::SHM_V + vst1) = vs1; \
    _Pragma("unroll") for (int _i = 0; _i < KPT; ++_i) *(ALAS bf16x8*)(K_lds + (b) * G::SHM_K + klo[_i]) = ks[_i]; } while (0)
#define A_SWAIT() asm volatile("s_waitcnt vmcnt(0)" ::: "memory")
#define A_RESC(a) do { if (__any((a) < 1.f)) { if (hi == 0) al_l[r32] = (a); asm volatile("s_waitcnt lgkmcnt(0)" ::: "memory"); \
    _Pragma("unroll") for (int _r = 0; _r < 16; ++_r) { const float _s = al_l[crow(_r, hi)]; _Pragma("unroll") for (int _d = 0; _d < 4; ++_d) o[_d][_r] *= _s; } } } while (0)
  f32x16 pA0, pA1, pB0, pB1; float mnA, mnB, alA, alB; bf16x8 pa0, pa1, pa2, pa3;
  A_SLOAD(0); A_SWAIT(); A_SWRITE(0); __syncthreads();
  qkt<KW, ND0, NDL>(pA0, pA1, K_lds, qr, QL, r32, hi, kcb0); hook(pA0, pA1, 0); partialSM<P>(pA0, pA1, m_reg, mnA, alA);
  A_SLOAD(64); A_SWAIT(); A_SWRITE(1); __syncthreads();
  for (int j = 1; j + 1 < NT; j += 2) {
    ASBAR(); qkt<KW, ND0, NDL>(pB0, pB1, K_lds + G::SHM_K, qr, QL, r32, hi, kcb0); hook(pB0, pB1, j);
    finishSM(pA0, pA1, alA, l_reg, pa0, pa1, pa2, pa3); ASBAR();
    A_SLOAD((j + 1) * 64); ASBAR();
    pv_d0(o, vb0, pa0, pa1, pa2, pa3); partialSM<P>(pB0, pB1, m_reg, mnB, alB);
    __syncthreads(); A_SWAIT(); A_SWRITE(0);
    A_RESC(alB); __syncthreads();
    ASBAR(); qkt<KW, ND0, NDL>(pA0, pA1, K_lds, qr, QL, r32, hi, kcb0); hook(pA0, pA1, j + 1);
    finishSM(pB0, pB1, alB, l_reg, pa0, pa1, pa2, pa3); ASBAR();
    A_SLOAD((j + 2) * 64); ASBAR();
    pv_d0(o, vb0 + G::SHM_V, pa0, pa1, pa2, pa3); partialSM<P>(pA0, pA1, m_reg, mnA, alA);
    __syncthreads(); A_SWAIT(); A_SWRITE(1);
    A_RESC(alA); __syncthreads();
  }
  ASBAR(); qkt<KW, ND0, NDL>(pB0, pB1, K_lds + G::SHM_K, qr, QL, r32, hi, kcb0); hook(pB0, pB1, NT - 1);
  finishSM(pA0, pA1, alA, l_reg, pa0, pa1, pa2, pa3); ASBAR();
  pv_d0(o, vb0, pa0, pa1, pa2, pa3); partialSM<P>(pB0, pB1, m_reg, mnB, alB);
  __syncthreads(); A_RESC(alB);
  finishSM(pB0, pB1, alB, l_reg, pa0, pa1, pa2, pa3); ASBAR();
  pv_d0(o, vb0 + G::SHM_V, pa0, pa1, pa2, pa3);
  if (hi == 0) li_l[r32] = l_reg; asm volatile("s_waitcnt lgkmcnt(0)" ::: "memory");
#pragma unroll
  for (int r = 0; r < 16; ++r) { const float s = __builtin_amdgcn_rcpf(li_l[crow(r, hi)]);
#pragma unroll
    for (int d = 0; d < 4; ++d) o[d][r] *= s; }
#undef A_SLOAD
#undef A_SWRITE
#undef A_SWAIT
#undef A_RESC
}
template <int KW, int ND0, int NDL, class P, class Hook>
__device__ __forceinline__ void attn_core_simple(const bf16_t* __restrict__ Qw, const bf16_t* __restrict__ Kh, const bf16_t* __restrict__ Vh, const int ldk, const int ldv,
                                                 const int kcb0, const int NT, ALAS char* lds, const Hook& hook, f32x16 (&o)[4]) {
  typedef Geo<KW, NDL> G; constexpr int KROWB = KW * 2, KCH = KW / 8, KPT = (64 * KCH) / 512;
  int tid_ = threadIdx.x; asm volatile("" : "+v"(tid_));
  const int tid = tid_, wid = tid >> 6, lane = tid & 63, r32 = lane & 31, hi = lane >> 5;
  ALAS char* V_lds = lds; ALAS char* K_lds = lds + G::OFF_K;
  ALAS float* wsf = (ALAS float*)(lds + G::OFF_WS) + wid * 64; ALAS float* li_l = wsf; ALAS float* al_l = wsf + 32;
  float m_reg = -1e30f, l_reg = 0.f;
#pragma unroll
  for (int d = 0; d < 4; ++d) o[d] = f32x16{};
  bf16x8 qr[ND0 > 0 ? ND0 : 1]; ALAS char* QL = lds + G::OFF_Q + (wid * NDL * 64 + lane) * 16;
#pragma unroll
  for (int d0 = 0; d0 < ND0; ++d0) qr[d0] = *(const bf16x8*)(Qw + d0 * 16);
#pragma unroll
  for (int d0 = 0; d0 < NDL; ++d0) *(ALAS bf16x8*)(QL + d0 * 1024) = *(const bf16x8*)(Qw + (ND0 + d0) * 16);
  const int sr = tid >> 4, sc = (tid & 15) * 8, vst0 = v_st(sr, sc), vst1 = v_st(32 + sr, sc);
  int kgo[KPT], klo[KPT];
#pragma unroll
  for (int i = 0; i < KPT; ++i) { const int id = tid + i * 512, row = id / KCH, ch = id % KCH; kgo[i] = row * ldk + ch * 8; klo[i] = row * KROWB + ((ch * 16) ^ ((row & 7) << 4)); }
  const int vb0 = (int)(unsigned)(size_t)V_lds + v_rd_base(lane);
  bf16x8 vs0, vs1, ks[KPT];
#define A_SLOAD(k0) do { vs0 = *(const bf16x8*)(Vh + (long)((k0) + sr) * ldv + sc); vs1 = *(const bf16x8*)(Vh + (long)((k0) + 32 + sr) * ldv + sc); \
    _Pragma("unroll") for (int _i = 0; _i < KPT; ++_i) ks[_i] = *(const bf16x8*)(Kh + (long)(k0) * ldk + kgo[_i]); } while (0)
#define A_SWRITE(b) do { *(ALAS bf16x8*)(V_lds + (b) * G::SHM_V + vst0) = vs0; *(ALAS bf16x8*)(V_lds + (b) * G::SHM_V + vst1) = vs1; \
    _Pragma("unroll") for (int _i = 0; _i < KPT; ++_i) *(ALAS bf16x8*)(K_lds + (b) * G::SHM_K + klo[_i]) = ks[_i]; } while (0)
  f32x16 p0, p1; float mn, al; bf16x8 pa0, pa1, pa2, pa3;
  A_SLOAD(0); asm volatile("s_waitcnt vmcnt(0)" ::: "memory"); A_SWRITE(0); __syncthreads();
  for (int j = 0; j < NT; ++j) {
    const int b = j & 1;
    if (j + 1 < NT) A_SLOAD((j + 1) * 64);
    ASBAR(); qkt<KW, ND0, NDL>(p0, p1, K_lds + b * G::SHM_K, qr, QL, r32, hi, kcb0); hook(p0, p1, j);
    partialSM<P>(p0, p1, m_reg, mn, al);
    if (__any(al < 1.f)) { if (hi == 0) al_l[r32] = al; asm volatile("s_waitcnt lgkmcnt(0)" ::: "memory");
#pragma unroll
      for (int r = 0; r < 16; ++r) { const float sa = al_l[crow(r, hi)];
#pragma unroll
        for (int d = 0; d < 4; ++d) o[d][r] *= sa; } }
    finishSM(p0, p1, al, l_reg, pa0, pa1, pa2, pa3); ASBAR();
    pv_d0(o, vb0 + b * G::SHM_V, pa0, pa1, pa2, pa3);
    if (j + 1 < NT) { asm volatile("s_waitcnt vmcnt(0)" ::: "memory"); A_SWRITE(b ^ 1); }
    __syncthreads();
  }
  if (hi == 0) li_l[r32] = l_reg; asm volatile("s_waitcnt lgkmcnt(0)" ::: "memory");
#pragma unroll
  for (int r = 0; r < 16; ++r) { const float s = __builtin_amdgcn_rcpf(li_l[crow(r, hi)]);
#pragma unroll
    for (int d = 0; d < 4; ++d) o[d][r] *= s; }
#undef A_SLOAD
#undef A_SWRITE
}
}
constexpr int BATCH = 4, SEQ = 4096, DM = 4096, DEPTH = 2, M = BATCH * SEQ;
constexpr int NIN = 23616, NINP = 23808;
constexpr float LN_EPS = 1e-5f;
constexpr float DN_ALPHA = 1.4142135623730951f;
static_assert(M == pg8::TOK, "token count");
constexpr size_t MiB = 1u << 20;
constexpr size_t WS_CTL = 0, CTL_ZERO_BYTES = 1 * MiB;
constexpr size_t WS_ROPE = WS_CTL + CTL_ZERO_BYTES;
constexpr size_t WS_PART = WS_ROPE + 1 * MiB;
constexpr size_t SZ_WIN = (size_t)NINP * DM * 2, SZ_WUQ = (size_t)1536 * 1536 * 2, SZ_WUKV = (size_t)2048 * 512 * 2, SZ_WO = (size_t)3 * 4096 * 1024 * 2, SZ_WOUT = (size_t)4096 * 4096 * 2;
constexpr size_t WS_WIN = WS_PART + 2 * MiB;
constexpr size_t WS_WUQ = WS_WIN + DEPTH * SZ_WIN;
constexpr size_t WS_WUKV = WS_WUQ + DEPTH * SZ_WUQ;
constexpr size_t WS_WO = WS_WUKV + DEPTH * SZ_WUKV;
constexpr size_t WS_WOUT = WS_WO + DEPTH * SZ_WO;
constexpr size_t SZ_T1K = (size_t)M * 1024 * 2;
constexpr size_t WS_XBF = WS_WOUT + DEPTH * SZ_WOUT;
constexpr size_t WS_X1 = WS_XBF + (size_t)M * DM * 2;
constexpr size_t WS_AQKV = WS_X1 + (size_t)M * DM * 4;
constexpr size_t WS_AG = WS_AQKV + 3 * SZ_T1K;
constexpr size_t WS_CQB = WS_AG + SZ_T1K;
constexpr size_t WS_CKVB = WS_CQB + (size_t)M * 1536 * 2;
constexpr size_t WS_BG = WS_CKVB + (size_t)M * 512 * 2;
constexpr size_t WS_CQ = WS_BG + SZ_T1K, WS_CK = WS_CQ + SZ_T1K, WS_CV = WS_CK + SZ_T1K, WS_CG = WS_CV + SZ_T1K;
constexpr size_t WS_GATE = WS_CG + SZ_T1K;
constexpr size_t WS_QB = WS_GATE + (size_t)M * 12288 * 2;
constexpr size_t WS_KB = WS_QB + (size_t)M * 1536 * 2;
constexpr size_t WS_VB = WS_KB + (size_t)M * 1536 * 2;
constexpr size_t WS_Y3 = WS_VB + SZ_T1K;
constexpr size_t WS_MF = WS_Y3 + 3 * SZ_T1K;
constexpr size_t WS_MBF = WS_MF + (size_t)M * DM * 4;
constexpr size_t WS_END = WS_MBF + (size_t)M * DM * 2;
static_assert(WS_WIN % 256 == 0 && WS_XBF % 256 == 0 && WS_END < (size_t)3000 * MiB, "d_ws map");
constexpr int CW_TMO = 0, CW_CODE = 1;
constexpr int CW_BAR = 4096;
constexpr int NWAVES = 8;
constexpr int RING_OFF = 0, RING_BYTES = 139264;
constexpr int LDSCTL_OFF = RING_BYTES, MISC_OFF = LDSCTL_OFF + 320;
constexpr int LDS_BYTES = 147456;
static_assert(MISC_OFF + 128 <= LDS_BYTES, "LDS map");
constexpr int NA_TAB_OFF = 132 * 1024;
constexpr int DIFF_X_OFF = 68 * 1024;
static_assert(att::Geo<128, 0>::BYTES <= DIFF_X_OFF && DIFF_X_OFF + 65536 <= NA_TAB_OFF && att::Geo<128, 8>::BYTES <= NA_TAB_OFF && NA_TAB_OFF + 2048 <= RING_BYTES && att::Geo<192, 4>::BYTES <= RING_BYTES, "attention LDS");

#define GAS __attribute__((address_space(1)))
#define LAS __attribute__((address_space(3)))
typedef unsigned short bf16;
typedef unsigned v4u __attribute__((ext_vector_type(4)));
typedef float f32x4 __attribute__((ext_vector_type(4)));
typedef GAS unsigned gu32;
#define RLX_AGENT __ATOMIC_RELAXED, __HIP_MEMORY_SCOPE_AGENT
#define LDS_WAIT() asm volatile("s_waitcnt lgkmcnt(0)" ::: "memory")
#define VM_WAIT() asm volatile("s_waitcnt vmcnt(0)" ::: "memory")
__device__ __forceinline__ unsigned f2bf(float f) { unsigned u = __builtin_bit_cast(unsigned, f); return (u + 0x7fffu + ((u >> 16) & 1u)) >> 16; }
__device__ __forceinline__ unsigned pk2(float lo, float hi) { return f2bf(lo) | (f2bf(hi) << 16); }
__device__ __forceinline__ float bf2f(unsigned short b) { return __uint_as_float(((unsigned)b) << 16); }
#define XB_TMO      128
#define XB_XCNT(j)  (256  + 64 * (j))
#define XB_XSUB(j)  (1280 + 64 * (j))
#define XB_XGEN(j)  (2304 + 64 * (j))
#define XB_TOP      3328
#define XB_TOPGEN   3392
#define XCD_BAR_WORDS 3456
#define XB_SPIN_CAP (1u << 18)

__device__ __forceinline__ unsigned xb_ld(unsigned* p)              { return __hip_atomic_load(p, __ATOMIC_RELAXED, __HIP_MEMORY_SCOPE_AGENT); }
__device__ __forceinline__ unsigned xb_add(unsigned* p, unsigned v) { return __hip_atomic_fetch_add(p, v, __ATOMIC_RELAXED, __HIP_MEMORY_SCOPE_AGENT); }
__device__ __forceinline__ unsigned xb_xcc_id() { return (unsigned)__builtin_amdgcn_s_getreg((3 << 11) | 20) & 0xFu; }
#define XB_SPIN(cond, bar) do { unsigned _sp = 0; while (cond) { __builtin_amdgcn_s_sleep(1); \
    if ((++_sp & 255u) == 0u) { if (xb_ld(&(bar)[XB_TMO])) break; if (_sp > XB_SPIN_CAP) { atomicAdd(&(bar)[XB_TMO], 1u); break; } } } } while (0)

struct XcdBarrier {
    unsigned* bar; unsigned x;
    volatile LAS unsigned* st;
};

__device__ __forceinline__ XcdBarrier xcd_barrier_post(unsigned* bar, volatile LAS unsigned* st) {
    XcdBarrier b; b.bar = bar; b.x = xb_xcc_id(); b.st = st;
    if (threadIdx.x == 0) (void)xb_add(&bar[XB_XCNT(b.x)], 1u);
    return b;
}
__device__ __forceinline__ void xcd_barrier_complete(unsigned* bar, unsigned x, unsigned& nloc, unsigned& nx) {
    const unsigned G = gridDim.x * gridDim.y * gridDim.z;
    unsigned sum, cnt, mine, sp = 0u;
    for (;;) {
        sum = 0u; cnt = 0u; mine = 0u;
#pragma unroll
        for (unsigned j = 0; j < 16; ++j) { const unsigned c = xb_ld(&bar[XB_XCNT(j)]); sum += c; cnt += (c > 0u) ? 1u : 0u; mine = (j == x) ? c : mine; }
        if (sum == G) break;
        __builtin_amdgcn_s_sleep(1);
        if ((++sp & 255u) == 0u) { if (xb_ld(&bar[XB_TMO])) break; if (sp > XB_SPIN_CAP) { atomicAdd(&bar[XB_TMO], 1u); break; } }
    }
    nloc = mine > 0u ? mine : 1u; nx = cnt > 0u ? cnt : 1u;
}

__device__ __forceinline__ void xcd_barrier(const XcdBarrier& b) {
    asm volatile("s_waitcnt vmcnt(0)" ::: "memory");
    __syncthreads();
    if (threadIdx.x == 0) {
        unsigned* bar = b.bar;
        __builtin_amdgcn_s_waitcnt(0);
        unsigned nloc = b.st[0], nx = b.st[1];
        if (nloc == 0u) { xcd_barrier_complete(bar, b.x, nloc, nx); b.st[0] = nloc; b.st[1] = nx; }
        const unsigned old = xb_add(&bar[XB_XSUB(b.x)], 1u);
        const unsigned gen = old / nloc;
        if (old + 1u == (gen + 1u) * nloc) {
            __builtin_amdgcn_fence(__ATOMIC_RELEASE, "agent");
            asm volatile("s_waitcnt vmcnt(0)" ::: "memory");
            const unsigned og = xb_add(&bar[XB_TOP], 1u);
            const unsigned tg = og / nx;
            if (og + 1u == (tg + 1u) * nx) xb_add(&bar[XB_TOPGEN], 1u);
            else XB_SPIN(xb_ld(&bar[XB_TOPGEN]) == tg, bar);
            __builtin_amdgcn_fence(__ATOMIC_ACQUIRE, "agent");
            xb_add(&bar[XB_XGEN(b.x)], 1u);
            asm volatile("s_waitcnt vmcnt(0)" ::: "memory");
        } else {
            XB_SPIN(xb_ld(&bar[XB_XGEN(b.x)]) == gen, bar);
            __builtin_amdgcn_fence(__ATOMIC_ACQUIRE, "agent");
            asm volatile("s_waitcnt vmcnt(0)" ::: "memory");
        }
    }
    __syncthreads();
}
__device__ __forceinline__ float wave_sum(float v) {
#pragma unroll
    for (int o = 1; o < 64; o <<= 1) v += __shfl_xor(v, o);
    return v;
}
__device__ __forceinline__ int ropeperm(int o) { const int i = o & 31, s = o >> 5; return 8 * (i >> 2) + 4 * s + (i & 3); }
__device__ __forceinline__ int dst_row(int kind, int n) {
    if (kind == 1) {
        if (n < 6144) return n;
        if (n < 6208) return 23552 + ropeperm(n - 6144);
        if (n < 7232) return n - 64;
        if (n < 9280) { const int r = n - 7232; return 7168 + (r & ~63) + ropeperm(r & 63); }
        return n - 64;
    }
    if (kind == 2) { const int h = n / 192, off = n - h * 192; return off < 128 ? h * 128 + off : 1024 + h * 64 + ropeperm(off - 128); }
    return n;
}
__device__ __forceinline__ void p0_transpose_item(const float* W, int K, int N, bf16* WT, int kind, const float* rs, LAS float* scr, int item, int lane) {
    const int nblk = N / 32, kb = item / nblk, nb = item % nblk, k0 = 64 * kb, n0 = 32 * nb;
#pragma unroll 8
    for (int i = 0; i < 32; ++i) { const int kk = 2 * i + (lane >> 5); float v = W[(size_t)(k0 + kk) * N + n0 + (lane & 31)]; if (rs) v *= rs[k0 + kk]; scr[kk * 33 + (lane & 31)] = v; }
    LDS_WAIT(); asm volatile("" ::: "memory");
    const int c = lane & 7;
#pragma unroll
    for (int j = 0; j < 4; ++j) { const int n = (lane >> 3) + 8 * j; const LAS float* s = scr + (8 * c) * 33 + n;
        v4u o; o.x = pk2(s[0 * 33], s[1 * 33]); o.y = pk2(s[2 * 33], s[3 * 33]); o.z = pk2(s[4 * 33], s[5 * 33]); o.w = pk2(s[6 * 33], s[7 * 33]);
        *(GAS v4u*)(WT + (size_t)dst_row(kind, n0 + n) * K + k0 + 8 * c) = o; }
    LDS_WAIT(); asm volatile("" ::: "memory");
}
__device__ __forceinline__ void sincos_tab(int pos, int i, float& c, float& s) {
    const double invf = exp2(-(double)i * (13.287712379549449 / 32.0));
    const double x = (double)pos * invf; const double kq = rint(x * 0.6366197723675814); const double r = fma(-kq, 1.5707963267948966, x) - kq * 6.123233995736766e-17;
    const double r2 = r * r;
    double sp = -1.0 / 6227020800.0; sp = sp * r2 + 1.0 / 39916800.0; sp = sp * r2 - 1.0 / 362880.0; sp = sp * r2 + 1.0 / 5040.0; sp = sp * r2 - 1.0 / 120.0; sp = sp * r2 + 1.0 / 6.0; sp = r - r * r2 * sp;
    double cp = 1.0 / 479001600.0; cp = cp * r2 - 1.0 / 3628800.0; cp = cp * r2 + 1.0 / 40320.0; cp = cp * r2 - 1.0 / 720.0; cp = cp * r2 + 1.0 / 24.0; cp = cp * r2 - 0.5; cp = 1.0 + r2 * cp;
    const int q = ((int)kq) & 3;
    const double sv = (q == 0) ? sp : (q == 1) ? cp : (q == 2) ? -sp : -cp, cv = (q == 0) ? cp : (q == 1) ? -sp : (q == 2) ? -cp : sp;
    c = (float)cv; s = (float)sv;
}
typedef att::f32x16 f32x16;
__device__ __forceinline__ void store_gated(const f32x16 (&o)[4], const bf16* gate, bf16* y, size_t row0  , int hcol0, int r32, int hi) {
#pragma unroll
    for (int r = 0; r < 16; ++r) { const size_t ro = (row0 + att::crow(r, hi)) * 1024 + hcol0 + r32;
#pragma unroll
        for (int d = 0; d < 4; ++d) y[ro + 32 * d] = (bf16)f2bf(o[d][r] * bf2f(gate[ro + 32 * d])); }
}
struct NaHook {
    const LAS float* tab; int qc_, qrow, kr0, hi; unsigned cmask_;
    __device__ __forceinline__ void operator()(f32x16& p0, f32x16& p1, int j) const {
        const int kr = kr0 + j; int rs = qrow - 4; rs = rs < 0 ? 0 : (rs > 56 ? 56 : rs);
        const bool rowok = (kr >= rs) && (kr < rs + 8);
        const float rowpen = rowok ? 0.f : -__builtin_inff();
        int dr = kr - qrow + 7; dr = max(0, min(dr, 14));
        int qc = qc_; unsigned cmask = cmask_; asm volatile("" : "+v"(qc), "+v"(cmask));
        const LAS float* trow = tab + dr * 31 + (15 - qc);
#pragma unroll
        for (int r = 0; r < 16; ++r) { const int kc = att::crow(r, hi);
            { const int dc = max(qc - 15, min(kc, qc + 15)); const unsigned pen = (((cmask >> r) & 1u) - 1u) & 0xff800000u; p0[r] = (p0[r] + (trow[dc] + rowpen)) + __uint_as_float(pen); }
            { const int dc = max(qc - 15, min(kc + 32, qc + 15)); const unsigned pen = (((cmask >> (16 + r)) & 1u) - 1u) & 0xff800000u; p1[r] = (p1[r] + (trow[dc] + rowpen)) + __uint_as_float(pen); } }
    }
};
__device__ __forceinline__ void na_unit(int u, const bf16* AQ, const bf16* AK, const bf16* AV, const bf16* AG, bf16* YA, const float* rpb  , LAS unsigned char* lds) {
    const int b = u >> 7, h = (u >> 4) & 7, rg = u & 15, r0 = 4 * rg; int kr0 = r0 - 4; kr0 = kr0 < 0 ? 0 : (kr0 > 52 ? 52 : kr0);
    int tid_ = threadIdx.x; asm volatile("" : "+v"(tid_)); const int tid = tid_, wid = tid >> 6, lane = tid & 63, r32 = lane & 31, hi = lane >> 5;
    LAS float* tab = (LAS float*)(lds + NA_TAB_OFF);
    if (tid < 465) tab[tid] = rpb[h * 465 + tid] * (1.0f / att::PolNA::SCALE);
    const size_t tok0 = (size_t)b * SEQ + r0 * 64 + wid * 32;
    const int qc = (wid & 1) * 32 + r32; int cs = qc - 8; cs = cs < 0 ? 0 : (cs > 48 ? 48 : cs); unsigned cmask = 0u;
#pragma unroll
    for (int r = 0; r < 16; ++r) { const int kc = att::crow(r, hi); cmask |= ((unsigned)(kc - cs) < 16u ? 1u : 0u) << r; cmask |= ((unsigned)(kc + 32 - cs) < 16u ? 1u : 0u) << (16 + r); }
    NaHook hook{tab, qc, r0 + (wid >> 1), kr0, hi, cmask};
    const size_t kbase = ((size_t)b * SEQ + kr0 * 64) * 1024 + h * 128;
    f32x16 o[4];
    att::attn_core_simple<128, 0, 8, att::PolNA, NaHook>(AQ + (tok0 + r32) * 1024 + h * 128 + hi * 8, AK + kbase, AV + kbase, 1024, 1024, 0, 12, (LAS char*)lds, hook, o);
    store_gated(o, AG, YA, tok0, h * 128, r32, hi);
}
__device__ __forceinline__ void mla_unit(int u, const bf16* QB, const bf16* KB, const bf16* VB, const bf16* BG, bf16* YB, LAS unsigned char* lds) {
    const int b = u >> 7, h = (u >> 4) & 7, qb = u & 15;
    int tid_ = threadIdx.x; asm volatile("" : "+v"(tid_)); const int tid = tid_, wid = tid >> 6, lane = tid & 63, r32 = lane & 31, hi = lane >> 5;
    const size_t tok0 = (size_t)b * SEQ + qb * 256 + wid * 32;
    f32x16 o[4]; att::NoHook nh;
    att::attn_core_simple<192, 8, 4, att::PolMLA, att::NoHook>(QB + (tok0 + r32) * 1536 + h * 192 + hi * 8, KB + (size_t)b * SEQ * 1536 + h * 192, VB + (size_t)b * SEQ * 1024 + h * 128, 1536, 1024, 0, 64, (LAS char*)lds, nh, o);
    store_gated(o, BG, YB, tok0, h * 128, r32, hi);
}
__device__ __forceinline__ void diff_unit(int u, const bf16* CQ, const bf16* CK, const bf16* CV, const bf16* CG, bf16* YC, const float* subln, float lam, float one_m_lam_init, LAS unsigned char* lds) {
    const int b = u >> 8, h = (u >> 5) & 7, qb = u & 31;
    int tid_ = threadIdx.x; asm volatile("" : "+v"(tid_)); const int tid = tid_, wid = tid >> 6, lane = tid & 63, r32 = lane & 31, hi = lane >> 5, map = wid >> 2, w4 = wid & 3;
    const size_t tok0 = (size_t)b * SEQ + qb * 128 + w4 * 32; const size_t kvb = (size_t)b * SEQ * 1024 + h * 128;
    f32x16 o[4]; att::NoHook nh;
    att::attn_core<128, 4, 0, att::PolDiff, att::NoHook>(CQ + (tok0 + r32) * 1024 + h * 128 + map * 64 + hi * 8, CK + kvb, CV + kvb, 1024, 1024, map * 128, 64, (LAS char*)lds, nh, o);
    LAS float* X = (LAS float*)(lds + DIFF_X_OFF) + w4 * 64 + lane;
    if (map == 1) {
#pragma unroll
        for (int d = 0; d < 4; ++d)
#pragma unroll
            for (int r = 0; r < 16; ++r) X[(d * 16 + r) * 256] = o[d][r] * lam;
    }
    LDS_WAIT(); __syncthreads();
    if (map == 0) {
        float sub[4], ss[16];
#pragma unroll
        for (int d = 0; d < 4; ++d) sub[d] = subln[32 * d + r32] * one_m_lam_init;
#pragma unroll
        for (int r = 0; r < 16; ++r) { float s = 0.f;
#pragma unroll
            for (int d = 0; d < 4; ++d) { const float v = o[d][r] - X[(d * 16 + r) * 256]; o[d][r] = v; s += v * v; }
            ss[r] = s; }
#pragma unroll
        for (int off = 1; off < 32; off <<= 1)
#pragma unroll
            for (int r = 0; r < 16; ++r) ss[r] += __shfl_xor(ss[r], off);
#pragma unroll
        for (int r = 0; r < 16; ++r) { const float rn = rsqrtf(ss[r] * (1.0f / 128.0f) + 1e-6f); const size_t ro = (tok0 + att::crow(r, hi)) * 1024 + h * 128 + r32;
#pragma unroll
            for (int d = 0; d < 4; ++d) YC[ro + 32 * d] = (bf16)f2bf(o[d][r] * rn * sub[d] * bf2f(CG[ro + 32 * d])); }
    }
}
__device__ __forceinline__ void ln_row(const float* zrow, float* xf, bf16* xb, const float* g, const float* bta, int lane) {
    const GAS f32x4* zr = (const GAS f32x4*)zrow + lane;
    f32x4 v[16]; float s = 0.f;
#pragma unroll
    for (int j = 0; j < 16; ++j) { v[j] = zr[64 * j]; s += (v[j].x + v[j].y) + (v[j].z + v[j].w); }
    const float mean = wave_sum(s) * (1.f / DM); float s2 = 0.f;
#pragma unroll
    for (int j = 0; j < 16; ++j) { v[j] = v[j] - mean; s2 += (v[j].x * v[j].x + v[j].y * v[j].y) + (v[j].z * v[j].z + v[j].w * v[j].w); }
    const float rstd = 1.f / sqrtf(wave_sum(s2) * (1.f / DM) + LN_EPS);
    GAS f32x4* of = (GAS f32x4*)xf + lane; const GAS f32x4* gg = (const GAS f32x4*)g + lane; const GAS f32x4* bb = (const GAS f32x4*)bta + lane;
#pragma unroll
    for (int j = 0; j < 16; ++j) { const f32x4 y = v[j] * rstd * gg[64 * j] + bb[64 * j]; of[64 * j] = y;
        if (xb) ((GAS unsigned long long*)xb)[lane + 64 * j] = (unsigned long long)pk2(y.x, y.y) | ((unsigned long long)pk2(y.z, y.w) << 32); }
}
struct Args { const float* in[19]; float* out; unsigned char* ws; int ph_lo, ph_hi; };
constexpr int N_PHASES = 1 + 6 * DEPTH;
#ifndef PH_MASK
#define PH_MASK 0x7f
#endif
#ifndef P2_MASK
#define P2_MASK 15
#endif
#define IN(k) (lo <= (k) && (k) < hi)
#define SEAM(k) do { if (IN(k) && IN((k) + 1)) xcd_barrier(bar); } while (0)
template <int l> __device__ __forceinline__ void run_layer(const Args& args, LAS unsigned char* lds, const XcdBarrier& bar, const int lo, const int hi, const int G, const int bx, const int wave, const int lane) {
    unsigned char* ws = args.ws;
    const float* cosT = (const float*)(ws + WS_ROPE); const float* sinT = cosT + 4096 * 32;
    float* part = (float*)(ws + WS_PART);
    bf16* XBF = (bf16*)(ws + WS_XBF); float* X1 = (float*)(ws + WS_X1);
    bf16* AQKV = (bf16*)(ws + WS_AQKV); bf16* AG = (bf16*)(ws + WS_AG); bf16* CQB = (bf16*)(ws + WS_CQB); bf16* CKVB = (bf16*)(ws + WS_CKVB); bf16* BG = (bf16*)(ws + WS_BG);
    bf16* CQ = (bf16*)(ws + WS_CQ); bf16* CK = (bf16*)(ws + WS_CK); bf16* CV = (bf16*)(ws + WS_CV); bf16* CG = (bf16*)(ws + WS_CG); bf16* GATE = (bf16*)(ws + WS_GATE);
    bf16* QB = (bf16*)(ws + WS_QB); bf16* KB = (bf16*)(ws + WS_KB); bf16* VB = (bf16*)(ws + WS_VB); bf16* Y3 = (bf16*)(ws + WS_Y3);
    float* MF = (float*)(ws + WS_MF); bf16* MBF = (bf16*)(ws + WS_MBF);
    float* Z = args.out;

    (void)X1; (void)XBF;
        const int pb = 1 + 6 * l;
        if ((PH_MASK & 2) && IN(pb)) {
            pg8::Gemm g{XBF, (const bf16*)(ws + WS_WIN + l * SZ_WIN), M, NINP, DM}; pg8::StaticOrder S; S.init(M, NINP, G, bx);
            pg8::EpiH E{AQKV, AG, CQB, CKVB, BG, CQ, CK, CV, CG, GATE, KB, part, args.in[15] + (size_t)l * 12288, cosT, sinT};
            pg8::gemm_phase<pg8::EpiH, pg8::StaticOrder, true, true>(lds + RING_OFF, g, S, E);
        }
        SEAM(pb);
        if ((PH_MASK & 4) && IN(pb + 1)) {
            const float lam_init = (l == 0) ? 0.2f : 0.35550906759096926f;
            float lam;
            { const float a = wave_sum(args.in[7][l * 64 + lane] * args.in[8][l * 64 + lane]), b = wave_sum(args.in[9][l * 64 + lane] * args.in[10][l * 64 + lane]); lam = __expf(a) - __expf(b) + lam_init; }
            if (P2_MASK & 1) for (int u = bx; u < 1024; u += G) diff_unit(u, CQ, CK, CV, CG, Y3 + 2 * (size_t)M * 1024, args.in[11] + l * 128, lam, 1.0f - lam_init, lds);
            __syncthreads();
            if (P2_MASK & 2) for (int u = bx; u < 512; u += G) na_unit(u, AQKV, AQKV + (size_t)M * 1024, AQKV + 2 * (size_t)M * 1024, AG, Y3, args.in[6] + (size_t)l * 8 * 465, lds);
            __syncthreads();
            if (P2_MASK & 4) { pg8::Gemm g{CQB, (const bf16*)(ws + WS_WUQ + l * SZ_WUQ), M, 1536, 1536}; pg8::ListOrder S;
              if (G == 256) { S.nN = 6; S.first = bx; S.stride = 256; S.cnt = (bx < 128) ? 2 : 1; } else { S.nN = 6; S.first = bx; S.stride = G; S.cnt = (384 - bx + G - 1) / G; }
              pg8::EpiQ E{QB, part, cosT, sinT};
              pg8::gemm_phase<pg8::EpiQ, pg8::ListOrder, true, true>(lds + RING_OFF, g, S, E); }
            if (P2_MASK & 8) { pg8::Gemm g{CKVB, (const bf16*)(ws + WS_WUKV + l * SZ_WUKV), M, 2048, 512}; pg8::ListOrder S;
              if (G == 256) { S.nN = 8; if (bx < 128) { S.first = 384 + bx; S.stride = 1; S.cnt = 1; } else { S.first = bx - 128; S.stride = 128; S.cnt = 3; } } else { S.nN = 8; S.first = bx; S.stride = G; S.cnt = (512 - bx + G - 1) / G; }
              pg8::EpiKV E{KB, VB, part};
              pg8::gemm_phase<pg8::EpiKV, pg8::ListOrder, true, true>(lds + RING_OFF, g, S, E); }
        }
        SEAM(pb + 1);
        if ((PH_MASK & 8) && IN(pb + 2)) {
            for (int u = bx; u < 512; u += G) mla_unit(u, QB, KB, VB, BG, Y3 + (size_t)M * 1024, lds);
        }
        SEAM(pb + 2);
        if ((PH_MASK & 16) && IN(pb + 3)) {
            pg8::Gemm g{Y3, (const bf16*)(ws + WS_WO + l * SZ_WO), 3 * M, 3 * 4096, 1024}; pg8::MergeOrder S; S.b.init(M, DM, G, bx);
            pg8::EpiMerge E{GATE, MF, MBF};
            pg8::gemm_phase<pg8::EpiMerge, pg8::MergeOrder, true, true>(lds + RING_OFF, g, S, E);
        }
        SEAM(pb + 3);
        if ((PH_MASK & 32) && IN(pb + 4)) {
            pg8::Gemm g{MBF, (const bf16*)(ws + WS_WOUT + l * SZ_WOUT), M, DM, DM}; pg8::StaticOrder S; S.init(M, DM, G, bx);
            pg8::EpiZ E{(l == 0) ? args.in[0] : (const float*)X1, Z, DN_ALPHA};
            pg8::gemm_phase<pg8::EpiZ, pg8::StaticOrder, true, true>(lds + RING_OFF, g, S, E);
        }
        SEAM(pb + 4);
        if ((PH_MASK & 64) && IN(pb + 5)) {
            const int gw = bx * NWAVES + wave, NGW = G * NWAVES; const bool last = (l == DEPTH - 1);
            for (int m = gw; m < M; m += NGW) ln_row(Z + (size_t)m * DM, (last ? Z : X1) + (size_t)m * DM, last ? nullptr : XBF + (size_t)m * DM, args.in[17] + l * DM, args.in[18] + l * DM, lane);
        }
        SEAM(pb + 5);
}
__global__ void __launch_bounds__(NWAVES * 64, 2) mk_fwd(Args args) {
    extern __shared__ __attribute__((aligned(16))) unsigned char lds_raw[];
    LAS unsigned char* lds = (LAS unsigned char*)lds_raw;
    volatile LAS unsigned* MISC = (volatile LAS unsigned*)(lds + MISC_OFF);
    const int tid = threadIdx.x, lane = tid & 63, wave = __builtin_amdgcn_readfirstlane(tid >> 6);
    const int G = gridDim.x, bx = blockIdx.x;
    unsigned char* ws = args.ws;
    gu32* ctl = (gu32*)(ws + WS_CTL);
    for (int u = tid; u < (LDS_BYTES - LDSCTL_OFF) / 4; u += NWAVES * 64) ((LAS unsigned*)(lds + LDSCTL_OFF))[u] = 0u;
    __syncthreads();
    const int lo = args.ph_lo, hi = args.ph_hi;
    XcdBarrier bar; bar.bar = (unsigned*)(ctl + CW_BAR); bar.x = 0; bar.st = nullptr;
    if (hi - lo > 1) bar = xcd_barrier_post((unsigned*)(ctl + CW_BAR), MISC + 8);
    const float* cosT = (const float*)(ws + WS_ROPE); const float* sinT = cosT + 4096 * 32;
    float* part = (float*)(ws + WS_PART);
    bf16* XBF = (bf16*)(ws + WS_XBF); float* X1 = (float*)(ws + WS_X1);
    bf16* AQKV = (bf16*)(ws + WS_AQKV); bf16* AG = (bf16*)(ws + WS_AG); bf16* CQB = (bf16*)(ws + WS_CQB); bf16* CKVB = (bf16*)(ws + WS_CKVB); bf16* BG = (bf16*)(ws + WS_BG);
    bf16* CQ = (bf16*)(ws + WS_CQ); bf16* CK = (bf16*)(ws + WS_CK); bf16* CV = (bf16*)(ws + WS_CV); bf16* CG = (bf16*)(ws + WS_CG); bf16* GATE = (bf16*)(ws + WS_GATE);
    bf16* QB = (bf16*)(ws + WS_QB); bf16* KB = (bf16*)(ws + WS_KB); bf16* VB = (bf16*)(ws + WS_VB); bf16* Y3 = (bf16*)(ws + WS_Y3);
    float* MF = (float*)(ws + WS_MF); bf16* MBF = (bf16*)(ws + WS_MBF);
    float* Z = args.out;

    if ((PH_MASK & 1) && IN(0)) {
        LAS float* scr = (LAS float*)(lds + RING_OFF + wave * 16384);
        const int gw = bx * NWAVES + wave, NGW = G * NWAVES;
        constexpr int I_IN = (DM / 64) * (NIN / 32), I_UQ = (1536 / 64) * (1536 / 32), I_UKV = (512 / 64) * (2048 / 32), I_O = (1024 / 64) * (4096 / 32), I_OUT = (4096 / 64) * (4096 / 32);
        constexpr int I_LAYER = I_IN + I_UQ + I_UKV + 3 * I_O + I_OUT;
        for (int it = gw; it < DEPTH * I_LAYER; it += NGW) {
            const int l = it / I_LAYER; int r = it - l * I_LAYER;
            if (r < I_IN) { p0_transpose_item(args.in[1] + (size_t)l * DM * NIN, DM, NIN, (bf16*)(ws + WS_WIN + l * SZ_WIN), 1, nullptr, scr, r, lane); continue; } r -= I_IN;
            if (r < I_UQ) { p0_transpose_item(args.in[2] + (size_t)l * 1536 * 1536, 1536, 1536, (bf16*)(ws + WS_WUQ + l * SZ_WUQ), 2, args.in[3] + l * 1536, scr, r, lane); continue; } r -= I_UQ;
            if (r < I_UKV) { p0_transpose_item(args.in[4] + (size_t)l * 512 * 2048, 512, 2048, (bf16*)(ws + WS_WUKV + l * SZ_WUKV), 0, args.in[5] + l * 512, scr, r, lane); continue; } r -= I_UKV;
            if (r < 3 * I_O) { const int br = r / I_O; p0_transpose_item(args.in[12 + br] + (size_t)l * 1024 * 4096, 1024, 4096, (bf16*)(ws + WS_WO + l * SZ_WO) + (size_t)br * 4096 * 1024, 0, nullptr, scr, r - br * I_O, lane); continue; } r -= 3 * I_O;
            p0_transpose_item(args.in[16] + (size_t)l * 4096 * 4096, 4096, 4096, (bf16*)(ws + WS_WOUT + l * SZ_WOUT), 0, nullptr, scr, r, lane);
        }
        const size_t gt = (size_t)bx * (NWAVES * 64) + tid, NGT = (size_t)G * NWAVES * 64;
        for (int l = 0; l < DEPTH; ++l) {
            GAS v4u* z = (GAS v4u*)(ws + WS_WIN + l * SZ_WIN + (size_t)NIN * DM * 2);
            for (size_t i = gt; i < (size_t)(NINP - NIN) * DM * 2 / 16; i += NGT) z[i] = (v4u){0u, 0u, 0u, 0u};
        }
        { const GAS f32x4* xs = (const GAS f32x4*)args.in[0]; GAS v4u* xd = (GAS v4u*)XBF;
          for (size_t i = gt; i < (size_t)M * DM / 8; i += NGT) { const f32x4 a = xs[2 * i], b = xs[2 * i + 1]; xd[i] = (v4u){pk2(a.x, a.y), pk2(a.z, a.w), pk2(b.x, b.y), pk2(b.z, b.w)}; } }
        for (size_t i = gt; i < (size_t)4096 * 32; i += NGT) { float c, s; sincos_tab((int)(i >> 5), (int)(i & 31), c, s); ((float*)cosT)[i] = c; ((float*)sinT)[i] = s; }
    }
    SEAM(0);

    run_layer<0>(args, lds, bar, lo, hi, G, bx, wave, lane);
    run_layer<1>(args, lds, bar, lo, hi, G, bx, wave, lane);
#undef IN
#undef SEAM
}

extern "C" void kernel_launch(void* const* d_in, const int* in_sizes, int n_in, void* d_out, int out_size, void* d_ws, size_t ws_size, hipStream_t stream) {
    static int grid = 0;
    if (grid == 0) {
        if (n_in != 19 || in_sizes[0] != M * DM || out_size != M * DM || ws_size < WS_END) { fprintf(stderr, "kernel_launch: shape mismatch: n_in %d in0 %d out %d ws %zu (need %zu)\n", n_in, n_in > 0 ? in_sizes[0] : -1, out_size, ws_size, (size_t)WS_END); grid = -1; return; }
        int dev = 0, cus = 0, per_cu = 0;
        if (hipGetDevice(&dev) != hipSuccess || hipDeviceGetAttribute(&cus, hipDeviceAttributeMultiprocessorCount, dev) != hipSuccess) { fprintf(stderr, "kernel_launch: device query failed\n"); grid = -1; return; }
        if (hipFuncSetAttribute((const void*)mk_fwd, hipFuncAttributeMaxDynamicSharedMemorySize, LDS_BYTES) != hipSuccess) { fprintf(stderr, "kernel_launch: hipFuncSetAttribute failed\n"); grid = -1; return; }
        if (hipOccupancyMaxActiveBlocksPerMultiprocessor(&per_cu, (const void*)mk_fwd, NWAVES * 64, LDS_BYTES) != hipSuccess || per_cu < 1) fprintf(stderr, "kernel_launch: note: occupancy query reports %d workgroups per CU\n", per_cu);
        (void)hipGetLastError();
        grid = cus;
    }
    if (grid < 0) return;
    if (hipMemsetAsync((char*)d_ws + WS_CTL, 0, CTL_ZERO_BYTES, stream) != hipSuccess) { fprintf(stderr, "kernel_launch: memset failed\n"); return; }
    Args a{};
    for (int i = 0; i < 19; ++i) a.in[i] = (const float*)d_in[i];
    a.out = (float*)d_out; a.ws = (unsigned char*)d_ws;
#if MK_ONE_LAUNCH
    a.ph_lo = 0; a.ph_hi = N_PHASES;
    hipLaunchKernelGGL(mk_fwd, dim3(grid), dim3(NWAVES * 64), LDS_BYTES, stream, a);
#else
    for (int p = 0; p < N_PHASES; ++p) { a.ph_lo = p; a.ph_hi = p + 1; hipLaunchKernelGGL(mk_fwd, dim3(grid), dim3(NWAVES * 64), LDS_BYTES, stream, a); }
#endif
    const hipError_t le = hipPeekAtLastError();
    if (le != hipSuccess) fprintf(stderr, "kernel_launch: launch failed: %s\n", hipGetErrorName(le));
}
```

```cpp
#include <hip/hip_runtime.h>
#include <cstdio>
#include <cstdint>
#ifndef PROBE_ZERO_B
#define PROBE_ZERO_B 0
#endif
#ifndef REP_MASK
#define REP_MASK 0
#endif
#define NREP(bit) (((REP_MASK) >> (bit)) & 1 ? 2 : 1)
#ifndef MK_ONE_LAUNCH
#define MK_ONE_LAUNCH 1
#endif
namespace pg8 {
#define PG8_LAS __attribute__((address_space(3)))
typedef unsigned short bf16_t;
typedef short bf16x8 __attribute__((ext_vector_type(8)));
typedef float f32x4 __attribute__((ext_vector_type(4)));
typedef unsigned u32x4 __attribute__((ext_vector_type(4)));
constexpr int BM = 256, BK = 64, HALF = 128, HTB = HALF * BK * 2  , STAGE_BYTES = 8 * HTB, NXCD = 8, WGM = 8;

__host__ __device__ __forceinline__ int lds_byte(int r, int c) { const int st = (r >> 4) * 2 + (c >> 5), rr = r & 15, cc = c & 31, ob = rr * 64 + cc * 2; return st * 1024 + (ob ^ (((ob >> 9) & 1) << 5)); }
__host__ __device__ __forceinline__ void stage_rc(int b, int& R, int& C) { const int st = b / 1024, sb = b % 1024, swz = sb ^ (((sb >> 9) & 1) << 5); R = (st >> 1) * 16 + swz / 64; C = (st & 1) * 32 + (swz % 64) / 2; }
__host__ __device__ __forceinline__ int perm32(int rho) { const int n = rho >> 4, i = rho & 15; return 8 * (i >> 2) + 4 * n + (i & 3); }

struct Unit { int pm, pn; };
struct Gemm { const bf16_t* A; const bf16_t* Bt; int M, N, K; };

struct StaticOrder {
    int nM, nN, nwg, G, c;
    __host__ __device__ void init(int M, int N, int G_, int c_) { nM = M / BM; nN = N / BM; nwg = nM * nN; G = G_; c = c_; }
    __host__ __device__ bool next(int i, Unit& u) const {
        const long L = (long)i * G + c; if (L >= nwg) return false;
        int wgid = (int)L; { const int q = nwg / NXCD, r = nwg % NXCD, xcd = wgid % NXCD, off = wgid / NXCD; wgid = (xcd < r ? xcd * (q + 1) : r * (q + 1) + (xcd - r) * q) + off; }
        const int nig = WGM * nN, gid = wgid / nig, fm = gid * WGM, gsz = (nM - fm) < WGM ? (nM - fm) : WGM;
        u.pm = fm + ((wgid % nig) % gsz); u.pn = (wgid % nig) / gsz; return true;
    }
    __device__ __forceinline__ void a_ready(const Unit&) const {}
    __device__ __forceinline__ void done(const Unit&) const {}
};

__device__ __forceinline__ unsigned cvt_pk_bf16(float lo, float hi) { unsigned r; asm volatile("v_cvt_pk_bf16_f32 %0, %1, %2" : "=v"(r) : "v"(lo), "v"(hi)); return r; }
typedef float f32x2 __attribute__((ext_vector_type(2)));
__device__ __forceinline__ f32x2 gelu_pk(f32x2 v) {
    const f32x2 av = __builtin_elementwise_abs(v), d = av * 0.2316418882f + 1.0f;
    f32x2 t; t.x = __builtin_amdgcn_rcpf(d.x); t.y = __builtin_amdgcn_rcpf(d.y);
    f32x2 q = t * 0.5307027145f + (-0.7265760135f); q = q * t + 0.7107068705f; q = q * t + (-0.142248368f); q = q * t + 0.127414796f; q = q * t;
    const f32x2 s = (v * v) * (-0.72134752044f);
    f32x2 e; e.x = __builtin_amdgcn_exp2f(s.x); e.y = __builtin_amdgcn_exp2f(s.y);
    const f32x2 m = v * (q * e), r = v - m;
    f32x2 o; o.x = v.x < 0.f ? m.x : r.x; o.y = v.y < 0.f ? m.y : r.y; return o;
}

template <int ACT  > struct EpiBf16 {
    static constexpr bool PERM = true, AFTER_DRAIN = false; static_assert(ACT == 0 || ACT == 1, "EpiBf16: ACT is 0 (none) or 1 (gelu_pk)");
    bf16_t* O; int ldc; const float* bias; int split_cols; size_t split_stride; float scale0;
    __device__ __forceinline__ void operator()(const f32x4 (&acc)[2][2][4][2], const Unit& u, int wr, int wc, int fr, int fq) const {
        const int row0 = u.pm * BM + wr * 64 + fr; int colt = u.pn * BM; bf16_t* base = O;
        float sc = 1.f; if (split_cols) { const int t = colt / split_cols; base += (size_t)t * split_stride; colt -= t * split_cols; if (t == 0) sc = scale0; }
        const int col0 = colt + wc * 32 + 8 * fq, bcol0 = u.pn * BM + wc * 32 + 8 * fq;
        f32x4 bv[2][2];
#pragma unroll
        for (int bj = 0; bj < 2; ++bj)
#pragma unroll
            for (int n = 0; n < 2; ++n) bv[bj][n] = bias ? *(const f32x4*)(bias + bcol0 + bj * HALF + 4 * n) : (f32x4){0.f, 0.f, 0.f, 0.f};
#pragma unroll
        for (int ai = 0; ai < 2; ++ai)
#pragma unroll
            for (int m = 0; m < 4; ++m) { bf16_t* rowp = base + (size_t)(row0 + ai * HALF + m * 16) * ldc + col0;
#pragma unroll
                for (int bj = 0; bj < 2; ++bj) { f32x4 v0 = acc[ai][bj][m][0] + bv[bj][0], v1 = acc[ai][bj][m][1] + bv[bj][1];
                    if (ACT == 1) { f32x2 a = gelu_pk((f32x2){v0[0], v0[1]}), b = gelu_pk((f32x2){v0[2], v0[3]}), c = gelu_pk((f32x2){v1[0], v1[1]}), d = gelu_pk((f32x2){v1[2], v1[3]});
                        v0 = (f32x4){a.x, a.y, b.x, b.y}; v1 = (f32x4){c.x, c.y, d.x, d.y}; }
                    v0 = v0 * sc; v1 = v1 * sc; u32x4 w; w.x = cvt_pk_bf16(v0[0], v0[1]); w.y = cvt_pk_bf16(v0[2], v0[3]); w.z = cvt_pk_bf16(v1[0], v1[1]); w.w = cvt_pk_bf16(v1[2], v1[3]);
                    *(u32x4*)(rowp + bj * HALF) = w; } }
    }
};
typedef unsigned u32x2 __attribute__((ext_vector_type(2)));
__device__ __forceinline__ float sigm(float x) { return __builtin_amdgcn_rcpf(1.f + __builtin_amdgcn_exp2f(-1.4426950408889634f * x)); }
__device__ __forceinline__ f32x4 silu4(f32x4 v) { f32x4 o; o[0] = v[0] * sigm(v[0]); o[1] = v[1] * sigm(v[1]); o[2] = v[2] * sigm(v[2]); o[3] = v[3] * sigm(v[3]); return o; }
__device__ __forceinline__ f32x4 sigm4(f32x4 v) { f32x4 o; o[0] = sigm(v[0]); o[1] = sigm(v[1]); o[2] = sigm(v[2]); o[3] = sigm(v[3]); return o; }
__device__ __forceinline__ u32x4 pack8(f32x4 v0, f32x4 v1) { u32x4 w; w.x = cvt_pk_bf16(v0[0], v0[1]); w.y = cvt_pk_bf16(v0[2], v0[3]); w.z = cvt_pk_bf16(v1[0], v1[1]); w.w = cvt_pk_bf16(v1[2], v1[3]); return w; }
__device__ __forceinline__ u32x2 pack4(f32x4 v) { u32x2 w; w.x = cvt_pk_bf16(v[0], v[1]); w.y = cvt_pk_bf16(v[2], v[3]); return w; }
__device__ __forceinline__ f32x4 bf_lo4(u32x4 w) { f32x4 o; o[0] = __uint_as_float(w.x << 16); o[1] = __uint_as_float(w.x & 0xffff0000u); o[2] = __uint_as_float(w.y << 16); o[3] = __uint_as_float(w.y & 0xffff0000u); return o; }
__device__ __forceinline__ f32x4 bf_hi4(u32x4 w) { f32x4 o; o[0] = __uint_as_float(w.z << 16); o[1] = __uint_as_float(w.z & 0xffff0000u); o[2] = __uint_as_float(w.w << 16); o[3] = __uint_as_float(w.w & 0xffff0000u); return o; }
constexpr int TOK = 16384;
struct EpiH {
    static constexpr bool PERM = true, AFTER_DRAIN = false;
    bf16_t *AQKV, *AG, *CQB, *CKVB, *BG, *CQ, *CK, *CV, *CG, *GATE, *KB; float* part; const float* bmerge; const float* cosT; const float* sinT;
    __device__ __forceinline__ void operator()(const f32x4 (&acc)[2][2][4][2], const Unit& u, int wr, int wc, int fr, int fq) const {
        const int pn = u.pn; const int row0 = u.pm * BM + wr * 64 + fr;
        if ((pn >= 28 && pn < 36) || pn == 92) {
            const int i0 = 4 * (4 * (wc & 1) + fq); f32x4 cs[2][4], sn[2][4];
#pragma unroll
            for (int ai = 0; ai < 2; ++ai)
#pragma unroll
                for (int m = 0; m < 4; ++m) { const int pos = (row0 + ai * HALF + m * 16) & 4095; cs[ai][m] = *(const f32x4*)(cosT + pos * 32 + i0); sn[ai][m] = *(const f32x4*)(sinT + pos * 32 + i0); }
            if (pn != 92) {
                bf16_t* dst = (pn < 32) ? CQ : CK; const int colt = ((pn - 28) & 3) * 256;
#pragma unroll
                for (int ai = 0; ai < 2; ++ai)
#pragma unroll
                    for (int m = 0; m < 4; ++m) { const int row = row0 + ai * HALF + m * 16;
#pragma unroll
                        for (int bj = 0; bj < 2; ++bj) { const f32x4 x1 = acc[ai][bj][m][0], x2 = acc[ai][bj][m][1]; const f32x4 o1 = x1 * cs[ai][m] - x2 * sn[ai][m], o2 = x2 * cs[ai][m] + x1 * sn[ai][m];
                            bf16_t* p = dst + (size_t)row * 1024 + colt + 64 * (2 * bj + (wc >> 1)) + i0; *(u32x2*)p = pack4(o1); *(u32x2*)(p + 32) = pack4(o2); } }
            } else if (wc < 2) {
#pragma unroll
                for (int ai = 0; ai < 2; ++ai)
#pragma unroll
                    for (int m = 0; m < 4; ++m) { const int row = row0 + ai * HALF + m * 16;
                        const f32x4 x1 = acc[ai][0][m][0], x2 = acc[ai][0][m][1]; const u32x2 w1 = pack4(x1 * cs[ai][m] - x2 * sn[ai][m]), w2 = pack4(x2 * cs[ai][m] + x1 * sn[ai][m]);
                        bf16_t* p = KB + (size_t)row * 1536 + 128 + i0;
#pragma unroll
                        for (int h = 0; h < 8; ++h) { *(u32x2*)(p + h * 192) = w1; *(u32x2*)(p + h * 192 + 32) = w2; } }
            }
            return; }
        bf16_t* dst; int ldc, colt, mode;
        if (pn < 12)      { mode = 0; dst = AQKV + (size_t)(pn >> 2) * TOK * 1024; ldc = 1024; colt = (pn & 3) * 256; }
        else if (pn < 16) { mode = 1; dst = AG; ldc = 1024; colt = (pn - 12) * 256; }
        else if (pn < 22) { mode = 4; dst = CQB; ldc = 1536; colt = (pn - 16) * 256; }
        else if (pn < 24) { mode = 4; dst = CKVB; ldc = 512; colt = (pn - 22) * 256; }
        else if (pn < 28) { mode = 1; dst = BG; ldc = 1024; colt = (pn - 24) * 256; }
        else if (pn < 40) { mode = 0; dst = CV; ldc = 1024; colt = (pn - 36) * 256; }
        else if (pn < 44) { mode = 1; dst = CG; ldc = 1024; colt = (pn - 40) * 256; }
        else              { mode = 3; dst = GATE; ldc = 12288; colt = (pn - 44) * 256; }
        const int col0 = colt + wc * 32 + 8 * fq;
        f32x4 bv[2][2];
#pragma unroll
        for (int bj = 0; bj < 2; ++bj)
#pragma unroll
            for (int n = 0; n < 2; ++n) bv[bj][n] = (mode == 3) ? *(const f32x4*)(bmerge + col0 + bj * HALF + 4 * n) : (f32x4){0.f, 0.f, 0.f, 0.f};
#pragma unroll
        for (int ai = 0; ai < 2; ++ai)
#pragma unroll
            for (int m = 0; m < 4; ++m) { const int row = row0 + ai * HALF + m * 16; bf16_t* rowp = dst + (size_t)row * ldc + col0; float ss = 0.f;
#pragma unroll
                for (int bj = 0; bj < 2; ++bj) { f32x4 v0 = acc[ai][bj][m][0], v1 = acc[ai][bj][m][1];
                    if (mode == 1) { v0 = silu4(v0); v1 = silu4(v1); }
                    if (mode == 3) { v0 = sigm4(v0 + bv[bj][0]); v1 = sigm4(v1 + bv[bj][1]); }
                    if (mode == 4) { const f32x4 q0 = v0 * v0, q1 = v1 * v1; ss += ((q0[0] + q0[1]) + (q0[2] + q0[3])) + ((q1[0] + q1[1]) + (q1[2] + q1[3])); }
                    if (mode == 3) { const f32x4 a = v0 * 255.f + 0.5f, b = v1 * 255.f + 0.5f;
                        u32x2 w; w.x = (unsigned)a[0] | ((unsigned)a[1] << 8) | ((unsigned)a[2] << 16) | ((unsigned)a[3] << 24); w.y = (unsigned)b[0] | ((unsigned)b[1] << 8) | ((unsigned)b[2] << 16) | ((unsigned)b[3] << 24);
                        *(u32x2*)((unsigned char*)GATE + (size_t)row * 12288 + col0 + bj * HALF) = w; }
                    else *(u32x4*)(rowp + bj * HALF) = pack8(v0, v1); }
                if (mode == 4) { ss += __shfl_xor(ss, 16); ss += __shfl_xor(ss, 32); if (fq == 0) part[(size_t)row * 32 + (pn - 16) * 4 + wc] = ss; } }
    }
};
struct EpiQ {
    static constexpr bool PERM = true, AFTER_DRAIN = false;
    bf16_t* QB; const float* part; const float* cosT; const float* sinT;
    __device__ __forceinline__ void operator()(const f32x4 (&acc)[2][2][4][2], const Unit& u, int wr, int wc, int fr, int fq) const {
        const int pn = u.pn; const int row0 = u.pm * BM + wr * 64 + fr; const int i0 = 4 * (4 * (wc & 1) + fq);
        const float wsel = (fq < 2) ? 1.f : 0.f;
#pragma unroll
        for (int ai = 0; ai < 2; ++ai) {
            float rs[4];
            { f32x4 pa[4], pb[4];
#pragma unroll
              for (int m = 0; m < 4; ++m) { const f32x4* pp = (const f32x4*)(part + (size_t)(row0 + ai * HALF + m * 16) * 32); pa[m] = pp[fq]; pb[m] = pp[4 + (fq & 1)]; }
#pragma unroll
              for (int m = 0; m < 4; ++m) { const f32x4 a = pa[m], b = pb[m];
                  float s = ((a[0] + a[1]) + (a[2] + a[3])) + wsel * ((b[0] + b[1]) + (b[2] + b[3])); s += __shfl_xor(s, 16); s += __shfl_xor(s, 32);
                  rs[m] = rsqrtf(s * (1.0f / 1536.0f) + 1e-6f); } }
            if (pn < 4) {
#pragma unroll
                for (int m = 0; m < 4; ++m) { const int row = row0 + ai * HALF + m * 16;
#pragma unroll
                    for (int bj = 0; bj < 2; ++bj) *(u32x4*)(QB + (size_t)row * 1536 + (2 * pn + bj) * 192 + wc * 32 + 8 * fq) = pack8(acc[ai][bj][m][0] * rs[m], acc[ai][bj][m][1] * rs[m]); }
            } else {
                f32x4 cs[4], sn[4];
#pragma unroll
                for (int m = 0; m < 4; ++m) { const int pos = (row0 + ai * HALF + m * 16) & 4095; cs[m] = *(const f32x4*)(cosT + pos * 32 + i0); sn[m] = *(const f32x4*)(sinT + pos * 32 + i0); }
#pragma unroll
                for (int m = 0; m < 4; ++m) { const int row = row0 + ai * HALF + m * 16;
#pragma unroll
                    for (int bj = 0; bj < 2; ++bj) { const f32x4 x1 = acc[ai][bj][m][0] * rs[m], x2 = acc[ai][bj][m][1] * rs[m]; const int head = 4 * (pn - 4) + 2 * bj + (wc >> 1);
                        bf16_t* p = QB + (size_t)row * 1536 + head * 192 + 128 + i0; *(u32x2*)p = pack4(x1 * cs[m] - x2 * sn[m]); *(u32x2*)(p + 32) = pack4(x2 * cs[m] + x1 * sn[m]); } }
            }
        }
    }
};
struct EpiKV {
    static constexpr bool PERM = true, AFTER_DRAIN = false;
    bf16_t* KB; bf16_t* VB; const float* part;
    __device__ __forceinline__ void operator()(const f32x4 (&acc)[2][2][4][2], const Unit& u, int wr, int wc, int fr, int fq) const {
        const int pn = u.pn; const int row0 = u.pm * BM + wr * 64 + fr;
        f32x4 pa[2][4];
#pragma unroll
        for (int ai = 0; ai < 2; ++ai)
#pragma unroll
            for (int m = 0; m < 4; ++m) pa[ai][m] = ((const f32x4*)(part + (size_t)(row0 + ai * HALF + m * 16) * 32 + 24))[fq & 1];
#pragma unroll
        for (int ai = 0; ai < 2; ++ai)
#pragma unroll
            for (int m = 0; m < 4; ++m) { const int row = row0 + ai * HALF + m * 16; const f32x4 a = pa[ai][m];
                float s = (a[0] + a[1]) + (a[2] + a[3]); s += __shfl_xor(s, 16);
                const float rs = rsqrtf(s * (1.0f / 512.0f) + 1e-6f);
                *(u32x4*)(KB + (size_t)row * 1536 + pn * 192 + wc * 32 + 8 * fq) = pack8(acc[ai][0][m][0] * rs, acc[ai][0][m][1] * rs);
                *(u32x4*)(VB + (size_t)row * 1024 + pn * 128 + wc * 32 + 8 * fq) = pack8(acc[ai][1][m][0] * rs, acc[ai][1][m][1] * rs); }
    }
};
struct EpiMerge {
    static constexpr bool PERM = true, AFTER_DRAIN = false;
    const bf16_t* GATE; float* MF; bf16_t* MBF;
    static __device__ __forceinline__ f32x4 u8x4(unsigned w) { f32x4 o; o[0] = (float)(w & 0xffu); o[1] = (float)((w >> 8) & 0xffu); o[2] = (float)((w >> 16) & 0xffu); o[3] = (float)(w >> 24); return o * (1.0f / 255.0f); }
    template <int SEG> __device__ __forceinline__ void run(const f32x4 (&acc)[2][2][4][2], int row0, int col0) const {
#pragma unroll
        for (int ai = 0; ai < 2; ++ai)
#pragma unroll
          for (int mh = 0; mh < 2; ++mh) { u32x2 g[2][2]; u32x4 p[2][2];
#pragma unroll
            for (int mm = 0; mm < 2; ++mm)
#pragma unroll
                for (int bj = 0; bj < 2; ++bj) { const size_t row = (size_t)(row0 + ai * HALF + (2 * mh + mm) * 16); const int c = col0 + bj * HALF;
                    g[mm][bj] = *(const u32x2*)((const unsigned char*)GATE + row * 12288 + SEG * 4096 + c);
                    if (SEG > 0) p[mm][bj] = *(const u32x4*)(MBF + row * 4096 + c); }
#pragma unroll
            for (int mm = 0; mm < 2; ++mm)
#pragma unroll
                for (int bj = 0; bj < 2; ++bj) { const int m = 2 * mh + mm; const size_t row = (size_t)(row0 + ai * HALF + m * 16); const int c = col0 + bj * HALF;
                    f32x4 v0 = acc[ai][bj][m][0] * u8x4(g[mm][bj].x), v1 = acc[ai][bj][m][1] * u8x4(g[mm][bj].y);
                    if (SEG > 0) { v0 += bf_lo4(p[mm][bj]); v1 += bf_hi4(p[mm][bj]); }
                    *(u32x4*)(MBF + row * 4096 + c) = pack8(v0, v1); } }
    }
    __device__ __forceinline__ void operator()(const f32x4 (&acc)[2][2][4][2], const Unit& u, int wr, int wc, int fr, int fq) const {
        const int seg = u.pm >> 6, pm = u.pm & 63, pn = u.pn & 15; const int row0 = pm * BM + wr * 64 + fr, col0 = pn * BM + wc * 32 + 8 * fq;
        if (seg == 0) run<0>(acc, row0, col0); else if (seg == 1) run<1>(acc, row0, col0); else run<2>(acc, row0, col0);
    }
};
struct EpiZ {
    static constexpr bool PERM = true, AFTER_DRAIN = false;
    const float* X; float* Z; float alpha;
    __device__ __forceinline__ void operator()(const f32x4 (&acc)[2][2][4][2], const Unit& u, int wr, int wc, int fr, int fq) const {
        const int row0 = u.pm * BM + wr * 64 + fr, col0 = u.pn * BM + wc * 32 + 8 * fq;
#pragma unroll
        for (int ai = 0; ai < 2; ++ai) { f32x4 x0[4][2], x1[4][2];
#pragma unroll
            for (int m = 0; m < 4; ++m)
#pragma unroll
                for (int bj = 0; bj < 2; ++bj) { const float* xp = X + (size_t)(row0 + ai * HALF + m * 16) * 4096 + col0 + bj * HALF; x0[m][bj] = *(const f32x4*)xp; x1[m][bj] = *(const f32x4*)(xp + 4); }
#pragma unroll
            for (int m = 0; m < 4; ++m)
#pragma unroll
                for (int bj = 0; bj < 2; ++bj) { float* zp = Z + (size_t)(row0 + ai * HALF + m * 16) * 4096 + col0 + bj * HALF;
                    *(f32x4*)zp = x0[m][bj] * alpha + acc[ai][bj][m][0]; *(f32x4*)(zp + 4) = x1[m][bj] * alpha + acc[ai][bj][m][1]; } }
    }
};
struct MergeOrder {
    StaticOrder b;
    __device__ __forceinline__ bool next(int i, Unit& u) const { Unit t; if (!b.next(i / 3, t)) return false; const int seg = i % 3; u.pm = seg * 64 + t.pm; u.pn = seg * 16 + t.pn; return true; }
    __device__ __forceinline__ void a_ready(const Unit&) const {}
    __device__ __forceinline__ void done(const Unit&) const {}
};
struct ListOrder {
    int nN, first, stride, cnt;
    __device__ __forceinline__ bool next(int i, Unit& u) const { if (i >= cnt) return false; const int L = first + i * stride; u.pm = L / nN; u.pn = L % nN; return true; }
    __device__ __forceinline__ void a_ready(const Unit&) const {}
    __device__ __forceinline__ void done(const Unit&) const {}
};
template <class Epi, class Sched, bool ALIGN_EPI = false, bool SP2 = false>
__device__ __forceinline__ void gemm_phase(PG8_LAS unsigned char* lds, const Gemm g, const Sched& S, const Epi& E) {
    int tid_ = threadIdx.x; asm volatile("" : "+v"(tid_));
    const int tid = tid_, wid = __builtin_amdgcn_readfirstlane(tid >> 6), lane = tid & 63, wr = wid >> 2, wc = wid & 3, fr = lane & 15, fq = lane >> 4;
    const int K = g.K, nt = K / BK;
    unsigned voffA[2], voffB[2];
#pragma unroll
    for (int i = 0; i < 2; ++i) { int R, C; stage_rc(tid * 16 + i * 8192, R, C); const int Rb = Epi::PERM ? ((R & ~31) + perm32(R & 31)) : R;
        voffA[i] = (unsigned)(R * K + C) * 2u; voffB[i] = (unsigned)(Rb * K + C) * 2u; }
    const size_t kstep = (size_t)(BK * 2);
    const size_t hstep = (size_t)HALF * K * 2;
    const size_t tstep = 2 * hstep;
    const unsigned ldsw = (unsigned)wid * 1024u;
    const int aoff = lds_byte(wr * 64 + fr, fq * 8), boff = lds_byte(wc * 32 + fr, fq * 8);
#define PG8_SA(b, h) (((b) * 2 + (h)) * HTB)
#define PG8_SB(b, h) ((4 + (b) * 2 + (h)) * HTB)
#define PG8_STAGE(bufoff, gbase, voff) do { _Pragma("unroll") for (int _i = 0; _i < 2; ++_i) \
        __builtin_amdgcn_global_load_lds((const unsigned*)((const char*)(gbase) + (voff)[_i]), (PG8_LAS unsigned*)(lds + (bufoff) + ldsw + _i * 8192), 16, 0, 0); } while (0)
#define PG8_LDA(dst, b, h) do { _Pragma("unroll") for (int m = 0; m < 4; ++m) _Pragma("unroll") for (int k = 0; k < 2; ++k) dst[m][k] = *(const PG8_LAS bf16x8*)(lds + PG8_SA(b, h) + aoff + m * 2048 + k * 1024); } while (0)
#define PG8_LDB(dst, b, h) do { _Pragma("unroll") for (int n = 0; n < 2; ++n) _Pragma("unroll") for (int k = 0; k < 2; ++k) dst[n][k] = *(const PG8_LAS bf16x8*)(lds + PG8_SB(b, h) + boff + n * 2048 + k * 1024); } while (0)
#define PG8_MMA(ai, bj, At, Bt) do { __builtin_amdgcn_s_setprio(1); _Pragma("unroll") for (int m = 0; m < 4; ++m) _Pragma("unroll") for (int n = 0; n < 2; ++n) _Pragma("unroll") for (int k = 0; k < 2; ++k) \
        acc[ai][bj][m][n] = __builtin_amdgcn_mfma_f32_16x16x32_bf16(Bt[n][k], At[m][k], acc[ai][bj][m][n], 0, 0, 0); __builtin_amdgcn_s_setprio(0); } while (0)
#define PG8_WAIT_V(n) asm volatile("s_waitcnt vmcnt(" #n ")" ::: "memory")
#define PG8_WAIT_L(n) asm volatile("s_waitcnt lgkmcnt(" #n ")" ::: "memory")
#define PG8_BAR __builtin_amdgcn_s_barrier()
#define PG8_SCHED __builtin_amdgcn_sched_barrier(0)
    Unit cur, nxt; int ui = 0;
    if (!S.next(0, cur)) return;
    f32x4 acc[2][2][4][2];
#pragma unroll
    for (int a = 0; a < 2; ++a)
#pragma unroll
        for (int b = 0; b < 2; ++b)
#pragma unroll
            for (int m = 0; m < 4; ++m)
#pragma unroll
                for (int n = 0; n < 2; ++n) acc[a][b][m][n] = (f32x4){0.f, 0.f, 0.f, 0.f};
    bf16x8 At[4][2], B0[2][2], B1[2][2];
    const char* cA = (const char*)g.A + (size_t)cur.pm * tstep; const char* cB = (const char*)g.Bt + (size_t)cur.pn * tstep;
    S.a_ready(cur);
    if constexpr (SP2) {
        PG8_STAGE(PG8_SB(0, 0), cB, voffB); PG8_STAGE(PG8_SB(0, 1), cB + hstep, voffB); PG8_STAGE(PG8_SA(0, 0), cA, voffA); PG8_STAGE(PG8_SA(0, 1), cA + hstep, voffA);
        if (wr == 1) PG8_BAR;
        PG8_WAIT_V(2); PG8_BAR;
        PG8_STAGE(PG8_SB(1, 0), cB + kstep, voffB); PG8_STAGE(PG8_SA(1, 0), cA + kstep, voffA); PG8_STAGE(PG8_SB(1, 1), cB + hstep + kstep, voffB);
        PG8_WAIT_V(6); PG8_BAR;
    } else {
        PG8_STAGE(PG8_SB(0, 0), cB, voffB); PG8_STAGE(PG8_SA(0, 0), cA, voffA); PG8_STAGE(PG8_SB(0, 1), cB + hstep, voffB); PG8_STAGE(PG8_SA(0, 1), cA + hstep, voffA);
        if (wr == 1) PG8_BAR;
        PG8_WAIT_V(4); PG8_BAR;
        PG8_STAGE(PG8_SB(1, 0), cB + kstep, voffB); PG8_STAGE(PG8_SA(1, 0), cA + kstep, voffA); PG8_STAGE(PG8_SB(1, 1), cB + hstep + kstep, voffB);
        PG8_WAIT_V(6); PG8_BAR;
    }
    for (;;) {
        const bool has_next = S.next(ui + 1, nxt);
        const char* nA = has_next ? (const char*)g.A + (size_t)nxt.pm * tstep : cA; const char* nB = has_next ? (const char*)g.Bt + (size_t)nxt.pn * tstep : cB;
        for (int t = 0; t < nt; t += 2) {
            const bool last = (t == nt - 2);
            const char* a1 = cA + (size_t)(t + 1) * kstep;
            const char* a2 = last ? nA : cA + (size_t)(t + 2) * kstep; const char* b2 = last ? nB : cB + (size_t)(t + 2) * kstep;
            const char* a3 = a2 + kstep; const char* b3 = b2 + kstep;
            if (last && has_next) S.a_ready(nxt);
            if constexpr (SP2) {
            PG8_LDB(B0, 0, 0); PG8_LDB(B1, 0, 1); PG8_SCHED; PG8_LDA(At, 0, 0); PG8_STAGE(PG8_SA(1, 1), a1 + hstep, voffA);
            PG8_WAIT_V(8); PG8_WAIT_L(0); PG8_BAR; PG8_MMA(0, 0, At, B0); PG8_MMA(0, 1, At, B1); PG8_BAR; PG8_SCHED;
            PG8_LDA(At, 0, 1); PG8_STAGE(PG8_SB(0, 0), b2, voffB); PG8_STAGE(PG8_SB(0, 1), b2 + hstep, voffB); PG8_STAGE(PG8_SA(0, 0), a2, voffA);
            PG8_WAIT_V(8); PG8_WAIT_L(0); PG8_BAR; PG8_MMA(1, 0, At, B0); PG8_MMA(1, 1, At, B1); PG8_BAR; PG8_SCHED;
            PG8_LDB(B0, 1, 0); PG8_LDB(B1, 1, 1); PG8_SCHED; PG8_LDA(At, 1, 0); PG8_STAGE(PG8_SA(0, 1), a2 + hstep, voffA);
            PG8_WAIT_V(8); PG8_WAIT_L(0); PG8_BAR; PG8_MMA(0, 0, At, B0); PG8_MMA(0, 1, At, B1); PG8_BAR; PG8_SCHED;
            PG8_LDA(At, 1, 1); PG8_STAGE(PG8_SB(1, 0), b3, voffB); PG8_STAGE(PG8_SB(1, 1), b3 + hstep, voffB); PG8_STAGE(PG8_SA(1, 0), a3, voffA);
            PG8_WAIT_V(8); PG8_WAIT_L(0); PG8_BAR; PG8_MMA(1, 0, At, B0); PG8_MMA(1, 1, At, B1); PG8_BAR; PG8_SCHED;
            } else {
            PG8_LDB(B0, 0, 0); PG8_SCHED; PG8_LDA(At, 0, 0); PG8_STAGE(PG8_SA(1, 1), a1 + hstep, voffA);
            PG8_WAIT_L(8); PG8_BAR; PG8_WAIT_L(0); PG8_MMA(0, 0, At, B0); PG8_BAR; PG8_SCHED;
            PG8_LDB(B1, 0, 1); PG8_STAGE(PG8_SB(0, 0), b2, voffB);
            PG8_BAR; PG8_WAIT_L(0); PG8_MMA(0, 1, At, B1); PG8_BAR;
            PG8_LDA(At, 0, 1); PG8_STAGE(PG8_SA(0, 0), a2, voffA);
            PG8_BAR; PG8_WAIT_L(0); PG8_MMA(1, 0, At, B0); PG8_BAR; PG8_SCHED;
            PG8_STAGE(PG8_SB(0, 1), b2 + hstep, voffB);
            PG8_WAIT_V(6); PG8_BAR; PG8_MMA(1, 1, At, B1); PG8_BAR;
            PG8_LDB(B0, 1, 0); PG8_SCHED; PG8_LDA(At, 1, 0); PG8_STAGE(PG8_SA(0, 1), a2 + hstep, voffA);
            PG8_WAIT_L(8); PG8_BAR; PG8_WAIT_L(0); PG8_MMA(0, 0, At, B0); PG8_BAR; PG8_SCHED;
            PG8_LDB(B1, 1, 1); PG8_STAGE(PG8_SB(1, 0), b3, voffB);
            PG8_BAR; PG8_WAIT_L(0); PG8_MMA(0, 1, At, B1); PG8_BAR;
            PG8_LDA(At, 1, 1); PG8_STAGE(PG8_SA(1, 0), a3, voffA);
            PG8_BAR; PG8_WAIT_L(0); PG8_MMA(1, 0, At, B0); PG8_BAR; PG8_SCHED;
            PG8_STAGE(PG8_SB(1, 1), b3 + hstep, voffB);
            PG8_WAIT_V(6); PG8_BAR; PG8_MMA(1, 1, At, B1); PG8_BAR;
            }
        }
        if constexpr (ALIGN_EPI) { if (wr == 0) PG8_BAR; }
        if constexpr (!Epi::AFTER_DRAIN) { E(acc, cur, wr, wc, fr, fq); S.done(cur); }
        if (!has_next) break;
#pragma unroll
        for (int a = 0; a < 2; ++a)
#pragma unroll
            for (int b = 0; b < 2; ++b)
#pragma unroll
                for (int m = 0; m < 4; ++m)
#pragma unroll
                    for (int n = 0; n < 2; ++n) acc[a][b][m][n] = (f32x4){0.f, 0.f, 0.f, 0.f};
        cur = nxt; cA = nA; cB = nB; ++ui;
        if constexpr (ALIGN_EPI) { if (wr == 1) PG8_BAR; }
    }
    PG8_WAIT_V(0);
    if constexpr (!ALIGN_EPI) { if (wr == 0) PG8_BAR; }
    PG8_BAR;
    if constexpr (Epi::AFTER_DRAIN) { E.fused(acc, cur, wr, wc, fr, fq, lds, wid, lane); S.done(cur); }
#undef PG8_SA
#undef PG8_SB
#undef PG8_STAGE
#undef PG8_LDA
#undef PG8_LDB
#undef PG8_MMA
#undef PG8_WAIT_V
#undef PG8_WAIT_L
#undef PG8_BAR
#undef PG8_SCHED
}
}
namespace att {
#define ALAS __attribute__((address_space(3)))
typedef unsigned short bf16_t;
typedef short bf16x8 __attribute__((ext_vector_type(8)));
typedef short s16x4 __attribute__((ext_vector_type(4)));
typedef float f32x16 __attribute__((ext_vector_type(16)));
typedef unsigned u32x4 __attribute__((ext_vector_type(4)));
#define ASBAR() __builtin_amdgcn_sched_barrier(0)
__device__ __forceinline__ int crow(int r, int hi) { return (r & 3) + 8 * (r >> 2) + 4 * hi; }
__device__ __forceinline__ unsigned cvtpk(float lo, float hi) { unsigned r; asm volatile("v_cvt_pk_bf16_f32 %0, %1, %2" : "=v"(r) : "v"(lo), "v"(hi)); return r; }
struct PolNA   { static constexpr float SCALE = 0.08838834764831845f; };
struct PolMLA  { static constexpr float SCALE = 0.07216878364870323f; };
struct PolDiff { static constexpr float SCALE = 0.125f; };
constexpr float ATHR = 8.f;
template <class P> __device__ __forceinline__ void partialSM(f32x16& p0, f32x16& p1, float& m_reg, float& mn, float& alpha) {
  constexpr float C = P::SCALE * 1.4426950408889634f;
  float pmax = p0[0];
#pragma unroll
  for (int r = 1; r < 16; ++r) pmax = fmaxf(pmax, p0[r]);
#pragma unroll
  for (int r = 0; r < 16; ++r) pmax = fmaxf(pmax, p1[r]);
  { auto rr = __builtin_amdgcn_permlane32_swap(__float_as_uint(pmax), __float_as_uint(pmax), false, false);
    pmax = fmaxf(__uint_as_float(rr[0]), __uint_as_float(rr[1])); }
  if (__builtin_expect(__all(pmax - m_reg <= ATHR / P::SCALE), 1)) { mn = m_reg; alpha = 1.f; }
  else { mn = fmaxf(m_reg, pmax); alpha = __builtin_amdgcn_exp2f((m_reg - mn) * C); m_reg = mn; }
  const float mnC = -mn * C;
#pragma unroll
  for (int r = 0; r < 16; ++r) p0[r] = fmaf(p0[r], C, mnC);
#pragma unroll
  for (int r = 0; r < 16; ++r) p1[r] = fmaf(p1[r], C, mnC);
#pragma unroll
  for (int r = 0; r < 16; ++r) p0[r] = __builtin_amdgcn_exp2f(p0[r]);
}
__device__ __forceinline__ void finishSM(f32x16& p0, f32x16& p1, float alpha, float& l_reg, bf16x8& pa0, bf16x8& pa1, bf16x8& pa2, bf16x8& pa3) {
#pragma unroll
  for (int r = 0; r < 16; ++r) p1[r] = __builtin_amdgcn_exp2f(p1[r]);
  float ps = 0;
#pragma unroll
  for (int r = 0; r < 16; ++r) ps += p0[r];
#pragma unroll
  for (int r = 0; r < 16; ++r) ps += p1[r];
  { auto rr = __builtin_amdgcn_permlane32_swap(__float_as_uint(ps), __float_as_uint(ps), false, false);
    ps = __uint_as_float(rr[0]) + __uint_as_float(rr[1]); }
  l_reg = l_reg * alpha + ps;
#define APK4(P, BASE, OUT) do { unsigned a0 = cvtpk(P[BASE + 0], P[BASE + 1]), a1 = cvtpk(P[BASE + 2], P[BASE + 3]);   \
    unsigned b0 = cvtpk(P[BASE + 4], P[BASE + 5]), b1 = cvtpk(P[BASE + 6], P[BASE + 7]);                              \
    auto r0 = __builtin_amdgcn_permlane32_swap(a0, b0, false, false); auto r1 = __builtin_amdgcn_permlane32_swap(a1, b1, false, false); \
    u32x4 w = {r0[0], r1[0], r0[1], r1[1]}; OUT = __builtin_bit_cast(bf16x8, w); } while (0)
  APK4(p0, 0, pa0); APK4(p0, 8, pa1); APK4(p1, 0, pa2); APK4(p1, 8, pa3);
#undef APK4
}
template <int KW, int ND0, int NDL> __device__ __forceinline__ void qkt(f32x16& p0, f32x16& p1, const ALAS char* Ks, const bf16x8 (&qr)[ND0 > 0 ? ND0 : 1], const ALAS char* QL_, int r32, int hi, int kcb0) {
  p0 = f32x16{}; p1 = f32x16{}; const ALAS char* QL = QL_;
  const int swz = (r32 & 7) << 4; const ALAS char* k0 = Ks + r32 * (KW * 2); const ALAS char* k1 = Ks + (32 + r32) * (KW * 2);
#pragma unroll
  for (int d0 = 0; d0 < ND0; ++d0) { const int cb = (kcb0 + d0 * 32 + hi * 16) ^ swz;
    const bf16x8 b0 = *(const ALAS bf16x8*)(k0 + cb); const bf16x8 b1 = *(const ALAS bf16x8*)(k1 + cb);
    p0 = __builtin_amdgcn_mfma_f32_32x32x16_bf16(b0, qr[d0], p0, 0, 0, 0);
    p1 = __builtin_amdgcn_mfma_f32_32x32x16_bf16(b1, qr[d0], p1, 0, 0, 0); }
  if (NDL > 0) asm volatile("" : "+v"(QL));
#pragma unroll
  for (int d0 = ND0; d0 < ND0 + NDL; ++d0) { const int cb = (kcb0 + d0 * 32 + hi * 16) ^ swz;
    const bf16x8 b0 = *(const ALAS bf16x8*)(k0 + cb); const bf16x8 b1 = *(const ALAS bf16x8*)(k1 + cb); const bf16x8 q = *(const ALAS bf16x8*)(QL + (d0 - ND0) * 1024);
    p0 = __builtin_amdgcn_mfma_f32_32x32x16_bf16(b0, q, p0, 0, 0, 0);
    p1 = __builtin_amdgcn_mfma_f32_32x32x16_bf16(b1, q, p1, 0, 0, 0); }
}
template <int KW, int ND0, int NDL, int GS> __device__ __forceinline__ void qkt_pf(f32x16& p0, f32x16& p1, const ALAS char* Ks, const bf16x8 (&qr)[ND0 > 0 ? ND0 : 1], const ALAS char* QL_, int r32, int hi, int kcb0) {
  constexpr int ND = ND0 + NDL, NG = (ND + GS - 1) / GS;
  p0 = f32x16{}; p1 = f32x16{}; const ALAS char* QL = QL_;
  if (NDL > 0) asm volatile("" : "+v"(QL));
  const int swz = (r32 & 7) << 4; const ALAS char* k0 = Ks + r32 * (KW * 2); const ALAS char* k1 = Ks + (32 + r32) * (KW * 2);
  bf16x8 b0[2][GS], b1[2][GS], ql[2][GS];
#define QKT_RD(g, buf) do { _Pragma("unroll") for (int _t = 0; _t < GS; ++_t) { const int _d = (g) * GS + _t; if (_d < ND) { const int _cb = (kcb0 + _d * 32 + hi * 16) ^ swz; \
      b0[buf][_t] = *(const ALAS bf16x8*)(k0 + _cb); b1[buf][_t] = *(const ALAS bf16x8*)(k1 + _cb); if (_d >= ND0) ql[buf][_t] = *(const ALAS bf16x8*)(QL + (_d - ND0) * 1024); } } } while (0)
  QKT_RD(0, 0);
#pragma unroll
  for (int g = 0; g < NG; ++g) {
    ASBAR();
    if (g + 1 < NG) QKT_RD(g + 1, (g + 1) & 1);
    ASBAR();
#pragma unroll
    for (int t = 0; t < GS; ++t) { const int d = g * GS + t; if (d < ND) { const bf16x8 q = (d < ND0) ? qr[d < ND0 ? d : 0] : ql[g & 1][t];
        p0 = __builtin_amdgcn_mfma_f32_32x32x16_bf16(b0[g & 1][t], q, p0, 0, 0, 0);
        p1 = __builtin_amdgcn_mfma_f32_32x32x16_bf16(b1[g & 1][t], q, p1, 0, 0, 0); } }
  }
#undef QKT_RD
}
__device__ __forceinline__ int v_st(int k, int c) { const int kk = (k & ~0xC) | ((k & 4) << 1) | ((k & 8) >> 1); return ((kk >> 3) * 4 + (c >> 5)) * 512 + ((kk & 7) * 32 + (c & 31)) * 2; }
__device__ __forceinline__ int v_rd_base(int lane) { return ((lane & 3) << 3) | (((lane >> 2) & 3) << 6) | (((lane >> 4) & 1) << 5) | (((lane >> 5) & 1) << 8); }
constexpr int v_rd_off(int d0, int ks, int half) { return d0 * 512 + ks * 4096 + half * 2048; }
template <int OFF> __device__ __forceinline__ s16x4 tr_read(int vb) { s16x4 r; asm volatile("ds_read_b64_tr_b16 %0, %1 offset:%2" : "=&v"(r) : "v"(vb), "i"(OFF) : "memory"); return r; }
template <int D0> __device__ __forceinline__ void pv_one(f32x16& od, int vb, bf16x8 pa0, bf16x8 pa1, bf16x8 pa2, bf16x8 pa3) {
  const s16x4 l0 = tr_read<v_rd_off(D0, 0, 0)>(vb), h0 = tr_read<v_rd_off(D0, 0, 1)>(vb), l1 = tr_read<v_rd_off(D0, 1, 0)>(vb), h1 = tr_read<v_rd_off(D0, 1, 1)>(vb);
  const s16x4 l2 = tr_read<v_rd_off(D0, 2, 0)>(vb), h2 = tr_read<v_rd_off(D0, 2, 1)>(vb), l3 = tr_read<v_rd_off(D0, 3, 0)>(vb), h3 = tr_read<v_rd_off(D0, 3, 1)>(vb);
  asm volatile("s_waitcnt lgkmcnt(0)" ::: "memory"); ASBAR();
#define APK(L, H) (bf16x8){L[0], L[1], L[2], L[3], H[0], H[1], H[2], H[3]}
  od = __builtin_amdgcn_mfma_f32_32x32x16_bf16(pa0, APK(l0, h0), od, 0, 0, 0);
  od = __builtin_amdgcn_mfma_f32_32x32x16_bf16(pa1, APK(l1, h1), od, 0, 0, 0);
  od = __builtin_amdgcn_mfma_f32_32x32x16_bf16(pa2, APK(l2, h2), od, 0, 0, 0);
  od = __builtin_amdgcn_mfma_f32_32x32x16_bf16(pa3, APK(l3, h3), od, 0, 0, 0);
#undef APK
}
__device__ __forceinline__ void pv_d0(f32x16 (&o)[4], int vb, bf16x8 pa0, bf16x8 pa1, bf16x8 pa2, bf16x8 pa3) {
  pv_one<0>(o[0], vb, pa0, pa1, pa2, pa3); pv_one<1>(o[1], vb, pa0, pa1, pa2, pa3); pv_one<2>(o[2], vb, pa0, pa1, pa2, pa3); pv_one<3>(o[3], vb, pa0, pa1, pa2, pa3);
}
template <int D0> __device__ __forceinline__ void pv_rd8(int vb, s16x4 (&x)[8]) {
  x[0] = tr_read<v_rd_off(D0, 0, 0)>(vb); x[1] = tr_read<v_rd_off(D0, 0, 1)>(vb); x[2] = tr_read<v_rd_off(D0, 1, 0)>(vb); x[3] = tr_read<v_rd_off(D0, 1, 1)>(vb);
  x[4] = tr_read<v_rd_off(D0, 2, 0)>(vb); x[5] = tr_read<v_rd_off(D0, 2, 1)>(vb); x[6] = tr_read<v_rd_off(D0, 3, 0)>(vb); x[7] = tr_read<v_rd_off(D0, 3, 1)>(vb);
}
__device__ __forceinline__ void pv_mma4(f32x16& od, const s16x4 (&x)[8], bf16x8 pa0, bf16x8 pa1, bf16x8 pa2, bf16x8 pa3) {
#define APK(L, H) (bf16x8){L[0], L[1], L[2], L[3], H[0], H[1], H[2], H[3]}
  od = __builtin_amdgcn_mfma_f32_32x32x16_bf16(pa0, APK(x[0], x[1]), od, 0, 0, 0);
  od = __builtin_amdgcn_mfma_f32_32x32x16_bf16(pa1, APK(x[2], x[3]), od, 0, 0, 0);
  od = __builtin_amdgcn_mfma_f32_32x32x16_bf16(pa2, APK(x[4], x[5]), od, 0, 0, 0);
  od = __builtin_amdgcn_mfma_f32_32x32x16_bf16(pa3, APK(x[6], x[7]), od, 0, 0, 0);
#undef APK
}
__device__ __forceinline__ void pv_d0_pf(f32x16 (&o)[4], int vb, bf16x8 pa0, bf16x8 pa1, bf16x8 pa2, bf16x8 pa3) {
  s16x4 A[8], B[8];
  pv_rd8<0>(vb, A); pv_rd8<1>(vb, B);
  asm volatile("s_waitcnt lgkmcnt(8)" ::: "memory"); ASBAR(); pv_mma4(o[0], A, pa0, pa1, pa2, pa3); ASBAR();
  pv_rd8<2>(vb, A);
  asm volatile("s_waitcnt lgkmcnt(8)" ::: "memory"); ASBAR(); pv_mma4(o[1], B, pa0, pa1, pa2, pa3); ASBAR();
  pv_rd8<3>(vb, B);
  asm volatile("s_waitcnt lgkmcnt(8)" ::: "memory"); ASBAR(); pv_mma4(o[2], A, pa0, pa1, pa2, pa3); ASBAR();
  asm volatile("s_waitcnt lgkmcnt(0)" ::: "memory"); ASBAR(); pv_mma4(o[3], B, pa0, pa1, pa2, pa3);
}
struct NoHook { __device__ __forceinline__ void operator()(f32x16&, f32x16&, int) const {} };
template <int KW, int NDL> struct Geo { static constexpr int SHM_V = 16384, SHM_K = 64 * KW * 2, OFF_K = 2 * SHM_V, OFF_WS = OFF_K + 2 * SHM_K, OFF_Q = OFF_WS + 8 * 256, BYTES = OFF_Q + 8 * NDL * 1024; };
template <int KW, int ND0, int NDL, class P, class Hook>
__device__ __forceinline__ void attn_core(const bf16_t* __restrict__ Qw, const bf16_t* __restrict__ Kh, const bf16_t* __restrict__ Vh, const int ldk, const int ldv,
                                          const int kcb0, const int NT, ALAS char* lds, const Hook& hook, f32x16 (&o)[4]) {
  typedef Geo<KW, NDL> G; constexpr int KROWB = KW * 2, KCH = KW / 8, KPT = (64 * KCH) / 512;
  int tid_ = threadIdx.x; asm volatile("" : "+v"(tid_));
  const int tid = tid_, wid = tid >> 6, lane = tid & 63, r32 = lane & 31, hi = lane >> 5;
  ALAS char* V_lds = lds; ALAS char* K_lds = lds + G::OFF_K;
  ALAS float* wsf = (ALAS float*)(lds + G::OFF_WS) + wid * 64; ALAS float* li_l = wsf; ALAS float* al_l = wsf + 32;
  float m_reg = -1e30f, l_reg = 0.f;
#pragma unroll
  for (int d = 0; d < 4; ++d) o[d] = f32x16{};
  bf16x8 qr[ND0 > 0 ? ND0 : 1]; ALAS char* QL = lds + G::OFF_Q + (wid * NDL * 64 + lane) * 16;
#pragma unroll
  for (int d0 = 0; d0 < ND0; ++d0) qr[d0] = *(const bf16x8*)(Qw + d0 * 16);
#pragma unroll
  for (int d0 = 0; d0 < NDL; ++d0) *(ALAS bf16x8*)(QL + d0 * 1024) = *(const bf16x8*)(Qw + (ND0 + d0) * 16);
  const int sr = tid >> 4, sc = (tid & 15) * 8, vst0 = v_st(sr, sc), vst1 = v_st(32 + sr, sc);
  int kgo[KPT], klo[KPT];
#pragma unroll
  for (int i = 0; i < KPT; ++i) { const int id = tid + i * 512, row = id / KCH, ch = id % KCH; kgo[i] = row * ldk + ch * 8; klo[i] = row * KROWB + ((ch * 16) ^ ((row & 7) << 4)); }
  const int vb0 = (int)(unsigned)(size_t)V_lds + v_rd_base(lane);
  bf16x8 vs0, vs1, ks[KPT];
#define A_SLOAD(k0) do { vs0 = *(const bf16x8*)(Vh + (long)((k0) + sr) * ldv + sc); vs1 = *(const bf16x8*)(Vh + (long)((k0) + 32 + sr) * ldv + sc); \
    _Pragma("unroll") for (int _i = 0; _i < KPT; ++_i) ks[_i] = *(const bf16x8*)(Kh + (long)(k0) * ldk + kgo[_i]); } while (0)
#define A_SWRITE(b) do { *(ALAS bf16x8*)(V_lds + (b) * G::SHM_V + vst0) = vs0; *(ALAS bf16x8*)(V_lds + (b) * G::SHM_V + vst1) = vs1; \
    _Pragma("unroll") for (int _i = 0; _i < KPT; ++_i) *(ALAS bf16x8*)(K_lds + (b) * G::SHM_K + klo[_i]) = ks[_i]; } while (0)
#define A_SWAIT() asm volatile("s_waitcnt vmcnt(0)" ::: "memory")
#define A_RESC(a) do { if (__any((a) < 1.f)) { if (hi == 0) al_l[r32] = (a); asm volatile("s_waitcnt lgkmcnt(0)" ::: "memory"); \
    _Pragma("unroll") for (int _r = 0; _r < 16; ++_r) { const float _s = al_l[crow(_r, hi)]; _Pragma("unroll") for (int _d = 0; _d < 4; ++_d) o[_d][_r] *= _s; } } } while (0)
  f32x16 pA0, pA1, pB0, pB1; float mnA, mnB, alA, alB; bf16x8 pa0, pa1, pa2, pa3;
  A_SLOAD(0); A_SWAIT(); A_SWRITE(0); __syncthreads();
  qkt<KW, ND0, NDL>(pA0, pA1, K_lds, qr, QL, r32, hi, kcb0); hook(pA0, pA1, 0); partialSM<P>(pA0, pA1, m_reg, mnA, alA);
  A_SLOAD(64); A_SWAIT(); A_SWRITE(1); __syncthreads();
  for (int j = 1; j + 1 < NT; j += 2) {
    ASBAR(); qkt<KW, ND0, NDL>(pB0, pB1, K_lds + G::SHM_K, qr, QL, r32, hi, kcb0); hook(pB0, pB1, j);
    finishSM(pA0, pA1, alA, l_reg, pa0, pa1, pa2, pa3); ASBAR();
    A_SLOAD((j + 1) * 64); ASBAR();
    pv_d0(o, vb0, pa0, pa1, pa2, pa3); partialSM<P>(pB0, pB1, m_reg, mnB, alB);
    __syncthreads(); A_SWAIT(); A_SWRITE(0);
    A_RESC(alB); __syncthreads();
    ASBAR(); qkt<KW, ND0, NDL>(pA0, pA1, K_lds, qr, QL, r32, hi, kcb0); hook(pA0, pA1, j + 1);
    finishSM(pB0, pB1, alB, l_reg, pa0, pa1, pa2, pa3); ASBAR();
    A_SLOAD((j + 2) * 64); ASBAR();
    pv_d0(o, vb0 + G::SHM_V, pa0, pa1, pa2, pa3); partialSM<P>(pA0, pA1, m_reg, mnA, alA);
    __syncthreads(); A_SWAIT(); A_SWRITE(1);
    A_RESC(alA); __syncthreads();
  }
  ASBAR(); qkt<KW, ND0, NDL>(pB0, pB1, K_lds + G::SHM_K, qr, QL, r32, hi, kcb0); hook(pB0, pB1, NT - 1);
  finishSM(pA0, pA1, alA, l_reg, pa0, pa1, pa2, pa3); ASBAR();
  pv_d0(o, vb0, pa0, pa1, pa2, pa3); partialSM<P>(pB0, pB1, m_reg, mnB, alB);
  __syncthreads(); A_RESC(alB);
  finishSM(pB0, pB1, alB, l_reg, pa0, pa1, pa2, pa3); ASBAR();
  pv_d0(o, vb0 + G::SHM_V, pa0, pa1, pa2, pa3);
  if (hi == 0) li_l[r32] = l_reg; asm volatile("s_waitcnt lgkmcnt(0)" ::: "memory");
#pragma unroll
  for (int r = 0; r < 16; ++r) { const float s = __builtin_amdgcn_rcpf(li_l[crow(r, hi)]);
#pragma unroll
    for (int d = 0; d < 4; ++d) o[d][r] *= s; }
#undef A_SLOAD
#undef A_SWRITE
#undef A_SWAIT
#undef A_RESC
}
template <int KW, int ND0, int NDL, int PF, class P, class Hook>
__device__ __forceinline__ void attn_core_simple(const bf16_t* __restrict__ Qw, const bf16_t* __restrict__ Kh, const bf16_t* __restrict__ Vh, const int ldk, const int ldv,
                                                 const int kcb0, const int NT, ALAS char* lds, const Hook& hook, f32x16 (&o)[4]) {
  typedef Geo<KW, NDL> G; constexpr int KROWB = KW * 2, KCH = KW / 8, KPT = (64 * KCH) / 512;
  int tid_ = threadIdx.x; asm volatile("" : "+v"(tid_));
  const int tid = tid_, wid = tid >> 6, lane = tid & 63, r32 = lane & 31, hi = lane >> 5;
  ALAS char* V_lds = lds; ALAS char* K_lds = lds + G::OFF_K;
  ALAS float* wsf = (ALAS float*)(lds + G::OFF_WS) + wid * 64; ALAS float* li_l = wsf; ALAS float* al_l = wsf + 32;
  float m_reg = -1e30f, l_reg = 0.f;
#pragma unroll
  for (int d = 0; d < 4; ++d) o[d] = f32x16{};
  bf16x8 qr[ND0 > 0 ? ND0 : 1]; ALAS char* QL = lds + G::OFF_Q + (wid * NDL * 64 + lane) * 16;
#pragma unroll
  for (int d0 = 0; d0 < ND0; ++d0) qr[d0] = *(const bf16x8*)(Qw + d0 * 16);
#pragma unroll
  for (int d0 = 0; d0 < NDL; ++d0) *(ALAS bf16x8*)(QL + d0 * 1024) = *(const bf16x8*)(Qw + (ND0 + d0) * 16);
  const int sr = tid >> 4, sc = (tid & 15) * 8, vst0 = v_st(sr, sc), vst1 = v_st(32 + sr, sc);
  int kgo[KPT], klo[KPT];
#pragma unroll
  for (int i = 0; i < KPT; ++i) { const int id = tid + i * 512, row = id / KCH, ch = id % KCH; kgo[i] = row * ldk + ch * 8; klo[i] = row * KROWB + ((ch * 16) ^ ((row & 7) << 4)); }
  const int vb0 = (int)(unsigned)(size_t)V_lds + v_rd_base(lane);
  bf16x8 vs0, vs1, ks[KPT];
#define A_SLOAD(k0) do { vs0 = *(const bf16x8*)(Vh + (long)((k0) + sr) * ldv + sc); vs1 = *(const bf16x8*)(Vh + (long)((k0) + 32 + sr) * ldv + sc); \
    _Pragma("unroll") for (int _i = 0; _i < KPT; ++_i) ks[_i] = *(const bf16x8*)(Kh + (long)(k0) * ldk + kgo[_i]); } while (0)
#define A_SWRITE(b) do { *(ALAS bf16x8*)(V_lds + (b) * G::SHM_V + vst0) = vs0; *(ALAS bf16x8*)(V_lds + (b) * G::SHM_V + vst1) = vs1; \
    _Pragma("unroll") for (int _i = 0; _i < KPT; ++_i) *(ALAS bf16x8*)(K_lds + (b) * G::SHM_K + klo[_i]) = ks[_i]; } while (0)
  f32x16 p0, p1; float mn, al; bf16x8 pa0, pa1, pa2, pa3;
  A_SLOAD(0); asm volatile("s_waitcnt vmcnt(0)" ::: "memory"); A_SWRITE(0); __syncthreads();
  for (int j = 0; j < NT; ++j) {
    const int b = j & 1;
    if (j + 1 < NT) A_SLOAD((j + 1) * 64);
    ASBAR(); if constexpr (PF > 0) qkt_pf<KW, ND0, NDL, PF>(p0, p1, K_lds + b * G::SHM_K, qr, QL, r32, hi, kcb0); else qkt<KW, ND0, NDL>(p0, p1, K_lds + b * G::SHM_K, qr, QL, r32, hi, kcb0);
    hook(p0, p1, j);
    partialSM<P>(p0, p1, m_reg, mn, al);
    if (__any(al < 1.f)) { if (hi == 0) al_l[r32] = al; asm volatile("s_waitcnt lgkmcnt(0)" ::: "memory");
#pragma unroll
      for (int r = 0; r < 16; ++r) { const float sa = al_l[crow(r, hi)];
#pragma unroll
        for (int d = 0; d < 4; ++d) o[d][r] *= sa; } }
    finishSM(p0, p1, al, l_reg, pa0, pa1, pa2, pa3); ASBAR();
    if constexpr (PF > 0) pv_d0_pf(o, vb0 + b * G::SHM_V, pa0, pa1, pa2, pa3); else pv_d0(o, vb0 + b * G::SHM_V, pa0, pa1, pa2, pa3);
    if (j + 1 < NT) { asm volatile("s_waitcnt vmcnt(0)" ::: "memory"); A_SWRITE(b ^ 1); }
    __syncthreads();
  }
  if (hi == 0) li_l[r32] = l_reg; asm volatile("s_waitcnt lgkmcnt(0)" ::: "memory");
#pragma unroll
  for (int r = 0; r < 16; ++r) { const float s = __builtin_amdgcn_rcpf(li_l[crow(r, hi)]);
#pragma unroll
    for (int d = 0; d < 4; ++d) o[d][r] *= s; }
#undef A_SLOAD
#undef A_SWRITE
}
}
constexpr int BATCH = 4, SEQ = 4096, DM = 4096, DEPTH = 2, M = BATCH * SEQ;
constexpr int NIN = 23616, NINP = 23808;
constexpr float LN_EPS = 1e-5f;
constexpr float DN_ALPHA = 1.4142135623730951f;
static_assert(M == pg8::TOK, "token count");
constexpr size_t MiB = 1u << 20;
constexpr size_t WS_CTL = 0, CTL_ZERO_BYTES = 1 * MiB;
constexpr size_t WS_ROPE = WS_CTL + CTL_ZERO_BYTES;
constexpr size_t WS_PART = WS_ROPE + 1 * MiB;
constexpr size_t SZ_WIN = (size_t)NINP * DM * 2, SZ_WUQ = (size_t)1536 * 1536 * 2, SZ_WUKV = (size_t)2048 * 512 * 2, SZ_WO = (size_t)3 * 4096 * 1024 * 2, SZ_WOUT = (size_t)4096 * 4096 * 2;
constexpr size_t WS_WIN = WS_PART + 2 * MiB;
constexpr size_t WS_WUQ = WS_WIN + DEPTH * SZ_WIN;
constexpr size_t WS_WUKV = WS_WUQ + DEPTH * SZ_WUQ;
constexpr size_t WS_WO = WS_WUKV + DEPTH * SZ_WUKV;
constexpr size_t WS_WOUT = WS_WO + DEPTH * SZ_WO;
constexpr size_t SZ_T1K = (size_t)M * 1024 * 2;
constexpr size_t WS_XBF = WS_WOUT + DEPTH * SZ_WOUT;
constexpr size_t WS_X1 = WS_XBF + (size_t)M * DM * 2;
constexpr size_t WS_AQKV = WS_X1 + (size_t)M * DM * 4;
constexpr size_t WS_AG = WS_AQKV + 3 * SZ_T1K;
constexpr size_t WS_CQB = WS_AG + SZ_T1K;
constexpr size_t WS_CKVB = WS_CQB + (size_t)M * 1536 * 2;
constexpr size_t WS_BG = WS_CKVB + (size_t)M * 512 * 2;
constexpr size_t WS_CQ = WS_BG + SZ_T1K, WS_CK = WS_CQ + SZ_T1K, WS_CV = WS_CK + SZ_T1K, WS_CG = WS_CV + SZ_T1K;
constexpr size_t WS_GATE = WS_CG + SZ_T1K;
constexpr size_t WS_QB = WS_GATE + (size_t)M * 12288 * 2;
constexpr size_t WS_KB = WS_QB + (size_t)M * 1536 * 2;
constexpr size_t WS_VB = WS_KB + (size_t)M * 1536 * 2;
constexpr size_t WS_Y3 = WS_VB + SZ_T1K;
constexpr size_t WS_MF = WS_Y3 + 3 * SZ_T1K;
constexpr size_t WS_MBF = WS_MF + (size_t)M * DM * 4;
constexpr size_t WS_END = WS_MBF + (size_t)M * DM * 2;
static_assert(WS_WIN % 256 == 0 && WS_XBF % 256 == 0 && WS_END < (size_t)3000 * MiB, "d_ws map");
constexpr int CW_TMO = 0, CW_CODE = 1;
constexpr int CW_BAR = 4096;
constexpr int NWAVES = 8;
constexpr int RING_OFF = 0, RING_BYTES = 139264;
constexpr int LDSCTL_OFF = RING_BYTES, MISC_OFF = LDSCTL_OFF + 320;
constexpr int LDS_BYTES = 147456;
static_assert(MISC_OFF + 128 <= LDS_BYTES, "LDS map");
constexpr int NA_TAB_OFF = 132 * 1024;
constexpr int DIFF_X_OFF = 68 * 1024;
static_assert(att::Geo<128, 0>::BYTES <= DIFF_X_OFF && DIFF_X_OFF + 65536 <= NA_TAB_OFF && att::Geo<128, 8>::BYTES <= NA_TAB_OFF && NA_TAB_OFF + 2048 <= RING_BYTES && att::Geo<192, 4>::BYTES <= RING_BYTES, "attention LDS");

#define GAS __attribute__((address_space(1)))
#define LAS __attribute__((address_space(3)))
typedef unsigned short bf16;
typedef unsigned v4u __attribute__((ext_vector_type(4)));
typedef float f32x4 __attribute__((ext_vector_type(4)));
typedef GAS unsigned gu32;
#define RLX_AGENT __ATOMIC_RELAXED, __HIP_MEMORY_SCOPE_AGENT
#define LDS_WAIT() asm volatile("s_waitcnt lgkmcnt(0)" ::: "memory")
#define VM_WAIT() asm volatile("s_waitcnt vmcnt(0)" ::: "memory")
__device__ __forceinline__ unsigned f2bf(float f) { unsigned u = __builtin_bit_cast(unsigned, f); return (u + 0x7fffu + ((u >> 16) & 1u)) >> 16; }
__device__ __forceinline__ unsigned pk2(float lo, float hi) { return f2bf(lo) | (f2bf(hi) << 16); }
__device__ __forceinline__ float bf2f(unsigned short b) { return __uint_as_float(((unsigned)b) << 16); }
#define XB_TMO      128
#define XB_XCNT(j)  (256  + 64 * (j))
#define XB_XSUB(j)  (1280 + 64 * (j))
#define XB_XGEN(j)  (2304 + 64 * (j))
#define XB_TOP      3328
#define XB_TOPGEN   3392
#define XCD_BAR_WORDS 3456
#define XB_SPIN_CAP (1u << 18)

__device__ __forceinline__ unsigned xb_ld(unsigned* p)              { return __hip_atomic_load(p, __ATOMIC_RELAXED, __HIP_MEMORY_SCOPE_AGENT); }
__device__ __forceinline__ unsigned xb_add(unsigned* p, unsigned v) { return __hip_atomic_fetch_add(p, v, __ATOMIC_RELAXED, __HIP_MEMORY_SCOPE_AGENT); }
__device__ __forceinline__ unsigned xb_xcc_id() { return (unsigned)__builtin_amdgcn_s_getreg((3 << 11) | 20) & 0xFu; }
#define XB_SPIN(cond, bar) do { unsigned _sp = 0; while (cond) { __builtin_amdgcn_s_sleep(1); \
    if ((++_sp & 255u) == 0u) { if (xb_ld(&(bar)[XB_TMO])) break; if (_sp > XB_SPIN_CAP) { atomicAdd(&(bar)[XB_TMO], 1u); break; } } } } while (0)

struct XcdBarrier {
    unsigned* bar; unsigned x;
    volatile LAS unsigned* st;
};

__device__ __forceinline__ XcdBarrier xcd_barrier_post(unsigned* bar, volatile LAS unsigned* st) {
    XcdBarrier b; b.bar = bar; b.x = xb_xcc_id(); b.st = st;
    if (threadIdx.x == 0) (void)xb_add(&bar[XB_XCNT(b.x)], 1u);
    return b;
}
__device__ __forceinline__ void xcd_barrier_complete(unsigned* bar, unsigned x, unsigned& nloc, unsigned& nx) {
    const unsigned G = gridDim.x * gridDim.y * gridDim.z;
    unsigned sum, cnt, mine, sp = 0u;
    for (;;) {
        sum = 0u; cnt = 0u; mine = 0u;
#pragma unroll
        for (unsigned j = 0; j < 16; ++j) { const unsigned c = xb_ld(&bar[XB_XCNT(j)]); sum += c; cnt += (c > 0u) ? 1u : 0u; mine = (j == x) ? c : mine; }
        if (sum == G) break;
        __builtin_amdgcn_s_sleep(1);
        if ((++sp & 255u) == 0u) { if (xb_ld(&bar[XB_TMO])) break; if (sp > XB_SPIN_CAP) { atomicAdd(&bar[XB_TMO], 1u); break; } }
    }
    nloc = mine > 0u ? mine : 1u; nx = cnt > 0u ? cnt : 1u;
}

__device__ __forceinline__ void xcd_barrier(const XcdBarrier& b) {
    asm volatile("s_waitcnt vmcnt(0)" ::: "memory");
    __syncthreads();
    if (threadIdx.x == 0) {
        unsigned* bar = b.bar;
        __builtin_amdgcn_s_waitcnt(0);
        unsigned nloc = b.st[0], nx = b.st[1];
        if (nloc == 0u) { xcd_barrier_complete(bar, b.x, nloc, nx); b.st[0] = nloc; b.st[1] = nx; }
        const unsigned old = xb_add(&bar[XB_XSUB(b.x)], 1u);
        const unsigned gen = old / nloc;
        if (old + 1u == (gen + 1u) * nloc) {
            __builtin_amdgcn_fence(__ATOMIC_RELEASE, "agent");
            asm volatile("s_waitcnt vmcnt(0)" ::: "memory");
            const unsigned og = xb_add(&bar[XB_TOP], 1u);
            const unsigned tg = og / nx;
            if (og + 1u == (tg + 1u) * nx) xb_add(&bar[XB_TOPGEN], 1u);
            else XB_SPIN(xb_ld(&bar[XB_TOPGEN]) == tg, bar);
            __builtin_amdgcn_fence(__ATOMIC_ACQUIRE, "agent");
            xb_add(&bar[XB_XGEN(b.x)], 1u);
            asm volatile("s_waitcnt vmcnt(0)" ::: "memory");
        } else {
            XB_SPIN(xb_ld(&bar[XB_XGEN(b.x)]) == gen, bar);
            __builtin_amdgcn_fence(__ATOMIC_ACQUIRE, "agent");
            asm volatile("s_waitcnt vmcnt(0)" ::: "memory");
        }
    }
    __syncthreads();
}
__device__ __forceinline__ float wave_sum(float v) {
#pragma unroll
    for (int o = 1; o < 64; o <<= 1) v += __shfl_xor(v, o);
    return v;
}
__device__ __forceinline__ int ropeperm(int o) { const int i = o & 31, s = o >> 5; return 8 * (i >> 2) + 4 * s + (i & 3); }
__device__ __forceinline__ int dst_row(int kind, int n) {
    if (kind == 1) {
        if (n < 6144) return n;
        if (n < 6208) return 23552 + ropeperm(n - 6144);
        if (n < 7232) return n - 64;
        if (n < 9280) { const int r = n - 7232; return 7168 + (r & ~63) + ropeperm(r & 63); }
        return n - 64;
    }
    if (kind == 2) { const int h = n / 192, off = n - h * 192; return off < 128 ? h * 128 + off : 1024 + h * 64 + ropeperm(off - 128); }
    return n;
}
__device__ __forceinline__ void p0_transpose_item(const float* W, int K, int N, bf16* WT, int kind, const float* rs, LAS float* scr, int item, int lane) {
    const int nblk = N / 32, kb = item / nblk, nb = item % nblk, k0 = 64 * kb, n0 = 32 * nb;
#pragma unroll 8
    for (int i = 0; i < 32; ++i) { const int kk = 2 * i + (lane >> 5); float v = W[(size_t)(k0 + kk) * N + n0 + (lane & 31)]; if (rs) v *= rs[k0 + kk]; scr[kk * 33 + (lane & 31)] = v; }
    LDS_WAIT(); asm volatile("" ::: "memory");
    const int c = lane & 7;
#pragma unroll
    for (int j = 0; j < 4; ++j) { const int n = (lane >> 3) + 8 * j; const LAS float* s = scr + (8 * c) * 33 + n;
        v4u o; o.x = pk2(s[0 * 33], s[1 * 33]); o.y = pk2(s[2 * 33], s[3 * 33]); o.z = pk2(s[4 * 33], s[5 * 33]); o.w = pk2(s[6 * 33], s[7 * 33]);
        *(GAS v4u*)(WT + (size_t)dst_row(kind, n0 + n) * K + k0 + 8 * c) = o; }
    LDS_WAIT(); asm volatile("" ::: "memory");
}
__device__ __forceinline__ void sincos_tab(int pos, int i, float& c, float& s) {
    const double invf = exp2(-(double)i * (13.287712379549449 / 32.0));
    const double x = (double)pos * invf; const double kq = rint(x * 0.6366197723675814); const double r = fma(-kq, 1.5707963267948966, x) - kq * 6.123233995736766e-17;
    const double r2 = r * r;
    double sp = -1.0 / 6227020800.0; sp = sp * r2 + 1.0 / 39916800.0; sp = sp * r2 - 1.0 / 362880.0; sp = sp * r2 + 1.0 / 5040.0; sp = sp * r2 - 1.0 / 120.0; sp = sp * r2 + 1.0 / 6.0; sp = r - r * r2 * sp;
    double cp = 1.0 / 479001600.0; cp = cp * r2 - 1.0 / 3628800.0; cp = cp * r2 + 1.0 / 40320.0; cp = cp * r2 - 1.0 / 720.0; cp = cp * r2 + 1.0 / 24.0; cp = cp * r2 - 0.5; cp = 1.0 + r2 * cp;
    const int q = ((int)kq) & 3;
    const double sv = (q == 0) ? sp : (q == 1) ? cp : (q == 2) ? -sp : -cp, cv = (q == 0) ? cp : (q == 1) ? -sp : (q == 2) ? -cp : sp;
    c = (float)cv; s = (float)sv;
}
typedef att::f32x16 f32x16;
__device__ __forceinline__ void store_gated(const f32x16 (&o)[4], const bf16* gate, bf16* y, size_t row0  , int hcol0, int r32, int hi) {
#pragma unroll
    for (int r = 0; r < 16; ++r) { const size_t ro = (row0 + att::crow(r, hi)) * 1024 + hcol0 + r32;
#pragma unroll
        for (int d = 0; d < 4; ++d) y[ro + 32 * d] = (bf16)f2bf(o[d][r] * bf2f(gate[ro + 32 * d])); }
}
struct NaHook {
    const LAS float* tab; int qc_, qrow, kr0, hi; unsigned cmask_;
    __device__ __forceinline__ void operator()(f32x16& p0, f32x16& p1, int j) const {
        const int kr = kr0 + j; int rs = qrow - 4; rs = rs < 0 ? 0 : (rs > 56 ? 56 : rs);
        const bool rowok = (kr >= rs) && (kr < rs + 8);
        const float rowpen = rowok ? 0.f : -__builtin_inff();
        int dr = kr - qrow + 7; dr = max(0, min(dr, 14));
        int qc = qc_; unsigned cmask = cmask_; asm volatile("" : "+v"(qc), "+v"(cmask));
        const LAS float* trow = tab + dr * 31 + (15 - qc);
#pragma unroll
        for (int r = 0; r < 16; ++r) { const int kc = att::crow(r, hi);
            { const int dc = max(qc - 15, min(kc, qc + 15)); const unsigned pen = (((cmask >> r) & 1u) - 1u) & 0xff800000u; p0[r] = (p0[r] + (trow[dc] + rowpen)) + __uint_as_float(pen); }
            { const int dc = max(qc - 15, min(kc + 32, qc + 15)); const unsigned pen = (((cmask >> (16 + r)) & 1u) - 1u) & 0xff800000u; p1[r] = (p1[r] + (trow[dc] + rowpen)) + __uint_as_float(pen); } }
    }
};
__device__ __forceinline__ void na_unit(int u, const bf16* AQ, const bf16* AK, const bf16* AV, const bf16* AG, bf16* YA, const float* rpb  , LAS unsigned char* lds) {
    const int b = u >> 7, h = (u >> 4) & 7, rg = u & 15, r0 = 4 * rg; int kr0 = r0 - 4; kr0 = kr0 < 0 ? 0 : (kr0 > 52 ? 52 : kr0);
    int tid_ = threadIdx.x; asm volatile("" : "+v"(tid_)); const int tid = tid_, wid = tid >> 6, lane = tid & 63, r32 = lane & 31, hi = lane >> 5;
    LAS float* tab = (LAS float*)(lds + NA_TAB_OFF);
    if (tid < 465) tab[tid] = rpb[h * 465 + tid] * (1.0f / att::PolNA::SCALE);
    const size_t tok0 = (size_t)b * SEQ + r0 * 64 + wid * 32;
    const int qc = (wid & 1) * 32 + r32; int cs = qc - 8; cs = cs < 0 ? 0 : (cs > 48 ? 48 : cs); unsigned cmask = 0u;
#pragma unroll
    for (int r = 0; r < 16; ++r) { const int kc = att::crow(r, hi); cmask |= ((unsigned)(kc - cs) < 16u ? 1u : 0u) << r; cmask |= ((unsigned)(kc + 32 - cs) < 16u ? 1u : 0u) << (16 + r); }
    NaHook hook{tab, qc, r0 + (wid >> 1), kr0, hi, cmask};
    const size_t kbase = ((size_t)b * SEQ + kr0 * 64) * 1024 + h * 128;
    f32x16 o[4];
    att::attn_core_simple<128, 0, 8, 0, att::PolNA, NaHook>(AQ + (tok0 + r32) * 1024 + h * 128 + hi * 8, AK + kbase, AV + kbase, 1024, 1024, 0, 12, (LAS char*)lds, hook, o);
    store_gated(o, AG, YA, tok0, h * 128, r32, hi);
}
__device__ __forceinline__ void mla_unit(int u, const bf16* QB, const bf16* KB, const bf16* VB, const bf16* BG, bf16* YB, LAS unsigned char* lds) {
    const int b = u >> 7, h = (u >> 4) & 7, qb = u & 15;
    int tid_ = threadIdx.x; asm volatile("" : "+v"(tid_)); const int tid = tid_, wid = tid >> 6, lane = tid & 63, r32 = lane & 31, hi = lane >> 5;
    const size_t tok0 = (size_t)b * SEQ + qb * 256 + wid * 32;
    f32x16 o[4]; att::NoHook nh;
    att::attn_core_simple<192, 8, 4, 0, att::PolMLA, att::NoHook>(QB + (tok0 + r32) * 1536 + h * 192 + hi * 8, KB + (size_t)b * SEQ * 1536 + h * 192, VB + (size_t)b * SEQ * 1024 + h * 128, 1536, 1024, 0, 64, (LAS char*)lds, nh, o);
    store_gated(o, BG, YB, tok0, h * 128, r32, hi);
}
__device__ __forceinline__ void diff_unit(int u, const bf16* CQ, const bf16* CK, const bf16* CV, const bf16* CG, bf16* YC, const float* subln, float lam, float one_m_lam_init, LAS unsigned char* lds) {
    const int b = u >> 8, h = (u >> 5) & 7, qb = u & 31;
    int tid_ = threadIdx.x; asm volatile("" : "+v"(tid_)); const int tid = tid_, wid = tid >> 6, lane = tid & 63, r32 = lane & 31, hi = lane >> 5, map = wid >> 2, w4 = wid & 3;
    const size_t tok0 = (size_t)b * SEQ + qb * 128 + w4 * 32; const size_t kvb = (size_t)b * SEQ * 1024 + h * 128;
    f32x16 o[4]; att::NoHook nh;
    att::attn_core_simple<128, 4, 0, 4, att::PolDiff, att::NoHook>(CQ + (tok0 + r32) * 1024 + h * 128 + map * 64 + hi * 8, CK + kvb, CV + kvb, 1024, 1024, map * 128, 64, (LAS char*)lds, nh, o);
    LAS float* X = (LAS float*)(lds + DIFF_X_OFF) + w4 * 64 + lane;
    if (map == 1) {
#pragma unroll
        for (int d = 0; d < 4; ++d)
#pragma unroll
            for (int r = 0; r < 16; ++r) X[(d * 16 + r) * 256] = o[d][r] * lam;
    }
    LDS_WAIT(); __syncthreads();
    if (map == 0) {
        float sub[4], ss[16];
#pragma unroll
        for (int d = 0; d < 4; ++d) sub[d] = subln[32 * d + r32] * one_m_lam_init;
#pragma unroll
        for (int r = 0; r < 16; ++r) { float s = 0.f;
#pragma unroll
            for (int d = 0; d < 4; ++d) { const float v = o[d][r] - X[(d * 16 + r) * 256]; o[d][r] = v; s += v * v; }
            ss[r] = s; }
#pragma unroll
        for (int off = 1; off < 32; off <<= 1)
#pragma unroll
            for (int r = 0; r < 16; ++r) ss[r] += __shfl_xor(ss[r], off);
#pragma unroll
        for (int r = 0; r < 16; ++r) { const float rn = rsqrtf(ss[r] * (1.0f / 128.0f) + 1e-6f); const size_t ro = (tok0 + att::crow(r, hi)) * 1024 + h * 128 + r32;
#pragma unroll
            for (int d = 0; d < 4; ++d) YC[ro + 32 * d] = (bf16)f2bf(o[d][r] * rn * sub[d] * bf2f(CG[ro + 32 * d])); }
    }
}
__device__ __forceinline__ void ln_row(const float* zrow, float* xf, bf16* xb, const float* g, const float* bta, int lane) {
    const GAS f32x4* zr = (const GAS f32x4*)zrow + lane;
    f32x4 v[16]; float s = 0.f;
#pragma unroll
    for (int j = 0; j < 16; ++j) { v[j] = zr[64 * j]; s += (v[j].x + v[j].y) + (v[j].z + v[j].w); }
    const float mean = wave_sum(s) * (1.f / DM); float s2 = 0.f;
#pragma unroll
    for (int j = 0; j < 16; ++j) { v[j] = v[j] - mean; s2 += (v[j].x * v[j].x + v[j].y * v[j].y) + (v[j].z * v[j].z + v[j].w * v[j].w); }
    const float rstd = 1.f / sqrtf(wave_sum(s2) * (1.f / DM) + LN_EPS);
    GAS f32x4* of = (GAS f32x4*)xf + lane; const GAS f32x4* gg = (const GAS f32x4*)g + lane; const GAS f32x4* bb = (const GAS f32x4*)bta + lane;
#pragma unroll
    for (int j = 0; j < 16; ++j) { const f32x4 y = v[j] * rstd * gg[64 * j] + bb[64 * j]; of[64 * j] = y;
        if (xb) ((GAS unsigned long long*)xb)[lane + 64 * j] = (unsigned long long)pk2(y.x, y.y) | ((unsigned long long)pk2(y.z, y.w) << 32); }
}
struct Args { const float* in[19]; float* out; unsigned char* ws; int ph_lo, ph_hi; };
constexpr int N_PHASES = 1 + 6 * DEPTH;
#ifndef PH_MASK
#define PH_MASK 0x7f
#endif
#ifndef P2_MASK
#define P2_MASK 15
#endif
#define IN(k) (lo <= (k) && (k) < hi)
#define SEAM(k) do { if (IN(k) && IN((k) + 1)) xcd_barrier(bar); } while (0)
template <int l> __device__ __forceinline__ void run_layer(const Args& args, LAS unsigned char* lds, const XcdBarrier& bar, const int lo, const int hi, const int G, const int bx, const int wave, const int lane) {
    unsigned char* ws = args.ws;
    const float* cosT = (const float*)(ws + WS_ROPE); const float* sinT = cosT + 4096 * 32;
    float* part = (float*)(ws + WS_PART);
    bf16* XBF = (bf16*)(ws + WS_XBF); float* X1 = (float*)(ws + WS_X1);
    bf16* AQKV = (bf16*)(ws + WS_AQKV); bf16* AG = (bf16*)(ws + WS_AG); bf16* CQB = (bf16*)(ws + WS_CQB); bf16* CKVB = (bf16*)(ws + WS_CKVB); bf16* BG = (bf16*)(ws + WS_BG);
    bf16* CQ = (bf16*)(ws + WS_CQ); bf16* CK = (bf16*)(ws + WS_CK); bf16* CV = (bf16*)(ws + WS_CV); bf16* CG = (bf16*)(ws + WS_CG); bf16* GATE = (bf16*)(ws + WS_GATE);
    bf16* QB = (bf16*)(ws + WS_QB); bf16* KB = (bf16*)(ws + WS_KB); bf16* VB = (bf16*)(ws + WS_VB); bf16* Y3 = (bf16*)(ws + WS_Y3);
    float* MF = (float*)(ws + WS_MF); bf16* MBF = (bf16*)(ws + WS_MBF);
    float* Z = args.out;

    (void)X1; (void)XBF;
        const int pb = 1 + 6 * l;
        if ((PH_MASK & 2) && IN(pb)) for (int rep = 0; rep < NREP(1); ++rep) {
            if (rep) __syncthreads();
            pg8::Gemm g{XBF, (const bf16*)(ws + WS_WIN + l * SZ_WIN), M, NINP, DM}; pg8::StaticOrder S; S.init(M, NINP, G, bx);
            pg8::EpiH E{AQKV, AG, CQB, CKVB, BG, CQ, CK, CV, CG, GATE, KB, part, args.in[15] + (size_t)l * 12288, cosT, sinT};
            pg8::gemm_phase<pg8::EpiH, pg8::StaticOrder, true, true>(lds + RING_OFF, g, S, E);
        }
        SEAM(pb);
        if ((PH_MASK & 4) && IN(pb + 1)) for (int rep = 0; rep < NREP(2); ++rep) {
            if (rep) __syncthreads();
            const float lam_init = (l == 0) ? 0.2f : 0.35550906759096926f;
            float lam;
            { const float a = wave_sum(args.in[7][l * 64 + lane] * args.in[8][l * 64 + lane]), b = wave_sum(args.in[9][l * 64 + lane] * args.in[10][l * 64 + lane]); lam = __expf(a) - __expf(b) + lam_init; }
            if (P2_MASK & 1) for (int u = bx; u < 1024; u += G) diff_unit(u, CQ, CK, CV, CG, Y3 + 2 * (size_t)M * 1024, args.in[11] + l * 128, lam, 1.0f - lam_init, lds);
            __syncthreads();
            if (P2_MASK & 2) for (int u = bx; u < 512; u += G) na_unit(u, AQKV, AQKV + (size_t)M * 1024, AQKV + 2 * (size_t)M * 1024, AG, Y3, args.in[6] + (size_t)l * 8 * 465, lds);
            __syncthreads();
            if (P2_MASK & 4) { pg8::Gemm g{CQB, (const bf16*)(ws + WS_WUQ + l * SZ_WUQ), M, 1536, 1536}; pg8::ListOrder S;
              if (G == 256) { S.nN = 6; S.first = bx; S.stride = 256; S.cnt = (bx < 128) ? 2 : 1; } else { S.nN = 6; S.first = bx; S.stride = G; S.cnt = (384 - bx + G - 1) / G; }
              pg8::EpiQ E{QB, part, cosT, sinT};
              pg8::gemm_phase<pg8::EpiQ, pg8::ListOrder, true, true>(lds + RING_OFF, g, S, E); }
            if (P2_MASK & 8) { pg8::Gemm g{CKVB, (const bf16*)(ws + WS_WUKV + l * SZ_WUKV), M, 2048, 512}; pg8::ListOrder S;
              if (G == 256) { S.nN = 8; if (bx < 128) { S.first = 384 + bx; S.stride = 1; S.cnt = 1; } else { S.first = bx - 128; S.stride = 128; S.cnt = 3; } } else { S.nN = 8; S.first = bx; S.stride = G; S.cnt = (512 - bx + G - 1) / G; }
              pg8::EpiKV E{KB, VB, part};
              pg8::gemm_phase<pg8::EpiKV, pg8::ListOrder, true, true>(lds + RING_OFF, g, S, E); }
        }
        SEAM(pb + 1);
        if ((PH_MASK & 8) && IN(pb + 2)) for (int rep = 0; rep < NREP(3); ++rep) {
            if (rep) __syncthreads();
#if PROBE_ZERO_B
            { GAS v4u* z = (GAS v4u*)(Y3 + (size_t)M * 1024); const size_t gt = (size_t)bx * 512 + threadIdx.x; for (size_t i = gt; i < (size_t)M * 1024 * 2 / 16; i += (size_t)G * 512) z[i] = (v4u){0u, 0u, 0u, 0u}; }
#else
            for (int u = bx; u < 512; u += G) mla_unit(u, QB, KB, VB, BG, Y3 + (size_t)M * 1024, lds);
#endif
        }
        SEAM(pb + 2);
        if ((PH_MASK & 16) && IN(pb + 3)) for (int rep = 0; rep < NREP(4); ++rep) {
            if (rep) __syncthreads();
            pg8::Gemm g{Y3, (const bf16*)(ws + WS_WO + l * SZ_WO), 3 * M, 3 * 4096, 1024}; pg8::MergeOrder S; S.b.init(M, DM, G, bx);
            pg8::EpiMerge E{GATE, MF, MBF};
            pg8::gemm_phase<pg8::EpiMerge, pg8::MergeOrder, true, true>(lds + RING_OFF, g, S, E);
        }
        SEAM(pb + 3);
        if ((PH_MASK & 32) && IN(pb + 4)) for (int rep = 0; rep < NREP(5); ++rep) {
            if (rep) __syncthreads();
            pg8::Gemm g{MBF, (const bf16*)(ws + WS_WOUT + l * SZ_WOUT), M, DM, DM}; pg8::StaticOrder S; S.init(M, DM, G, bx);
            pg8::EpiZ E{(l == 0) ? args.in[0] : (const float*)X1, Z, DN_ALPHA};
            pg8::gemm_phase<pg8::EpiZ, pg8::StaticOrder, true, true>(lds + RING_OFF, g, S, E);
        }
        SEAM(pb + 4);
        if ((PH_MASK & 64) && IN(pb + 5)) {
            const int gw = bx * NWAVES + wave, NGW = G * NWAVES; const bool last = (l == DEPTH - 1);
            for (int m = gw; m < M; m += NGW) ln_row(Z + (size_t)m * DM, (last ? Z : X1) + (size_t)m * DM, last ? nullptr : XBF + (size_t)m * DM, args.in[17] + l * DM, args.in[18] + l * DM, lane);
        }
        SEAM(pb + 5);
}
__global__ void __launch_bounds__(NWAVES * 64, 2) mk_fwd(Args args) {
    extern __shared__ __attribute__((aligned(16))) unsigned char lds_raw[];
    LAS unsigned char* lds = (LAS unsigned char*)lds_raw;
    volatile LAS unsigned* MISC = (volatile LAS unsigned*)(lds + MISC_OFF);
    const int tid = threadIdx.x, lane = tid & 63, wave = __builtin_amdgcn_readfirstlane(tid >> 6);
    const int G = gridDim.x, bx = blockIdx.x;
    unsigned char* ws = args.ws;
    gu32* ctl = (gu32*)(ws + WS_CTL);
    for (int u = tid; u < (LDS_BYTES - LDSCTL_OFF) / 4; u += NWAVES * 64) ((LAS unsigned*)(lds + LDSCTL_OFF))[u] = 0u;
    __syncthreads();
    const int lo = args.ph_lo, hi = args.ph_hi;
    XcdBarrier bar; bar.bar = (unsigned*)(ctl + CW_BAR); bar.x = 0; bar.st = nullptr;
    if (hi - lo > 1) bar = xcd_barrier_post((unsigned*)(ctl + CW_BAR), MISC + 8);
    const float* cosT = (const float*)(ws + WS_ROPE); const float* sinT = cosT + 4096 * 32;
    float* part = (float*)(ws + WS_PART);
    bf16* XBF = (bf16*)(ws + WS_XBF); float* X1 = (float*)(ws + WS_X1);
    bf16* AQKV = (bf16*)(ws + WS_AQKV); bf16* AG = (bf16*)(ws + WS_AG); bf16* CQB = (bf16*)(ws + WS_CQB); bf16* CKVB = (bf16*)(ws + WS_CKVB); bf16* BG = (bf16*)(ws + WS_BG);
    bf16* CQ = (bf16*)(ws + WS_CQ); bf16* CK = (bf16*)(ws + WS_CK); bf16* CV = (bf16*)(ws + WS_CV); bf16* CG = (bf16*)(ws + WS_CG); bf16* GATE = (bf16*)(ws + WS_GATE);
    bf16* QB = (bf16*)(ws + WS_QB); bf16* KB = (bf16*)(ws + WS_KB); bf16* VB = (bf16*)(ws + WS_VB); bf16* Y3 = (bf16*)(ws + WS_Y3);
    float* MF = (float*)(ws + WS_MF); bf16* MBF = (bf16*)(ws + WS_MBF);
    float* Z = args.out;

    if ((PH_MASK & 1) && IN(0)) for (int rep = 0; rep < NREP(0); ++rep) {
        if (rep) __syncthreads();
        LAS float* scr = (LAS float*)(lds + RING_OFF + wave * 16384);
        const int gw = bx * NWAVES + wave, NGW = G * NWAVES;
        constexpr int I_IN = (DM / 64) * (NIN / 32), I_UQ = (1536 / 64) * (1536 / 32), I_UKV = (512 / 64) * (2048 / 32), I_O = (1024 / 64) * (4096 / 32), I_OUT = (4096 / 64) * (4096 / 32);
        constexpr int I_LAYER = I_IN + I_UQ + I_UKV + 3 * I_O + I_OUT;
        for (int it = gw; it < DEPTH * I_LAYER; it += NGW) {
            const int l = it / I_LAYER; int r = it - l * I_LAYER;
            if (r < I_IN) { p0_transpose_item(args.in[1] + (size_t)l * DM * NIN, DM, NIN, (bf16*)(ws + WS_WIN + l * SZ_WIN), 1, nullptr, scr, r, lane); continue; } r -= I_IN;
            if (r < I_UQ) { p0_transpose_item(args.in[2] + (size_t)l * 1536 * 1536, 1536, 1536, (bf16*)(ws + WS_WUQ + l * SZ_WUQ), 2, args.in[3] + l * 1536, scr, r, lane); continue; } r -= I_UQ;
            if (r < I_UKV) { p0_transpose_item(args.in[4] + (size_t)l * 512 * 2048, 512, 2048, (bf16*)(ws + WS_WUKV + l * SZ_WUKV), 0, args.in[5] + l * 512, scr, r, lane); continue; } r -= I_UKV;
            if (r < 3 * I_O) { const int br = r / I_O; p0_transpose_item(args.in[12 + br] + (size_t)l * 1024 * 4096, 1024, 4096, (bf16*)(ws + WS_WO + l * SZ_WO) + (size_t)br * 4096 * 1024, 0, nullptr, scr, r - br * I_O, lane); continue; } r -= 3 * I_O;
            p0_transpose_item(args.in[16] + (size_t)l * 4096 * 4096, 4096, 4096, (bf16*)(ws + WS_WOUT + l * SZ_WOUT), 0, nullptr, scr, r, lane);
        }
        const size_t gt = (size_t)bx * (NWAVES * 64) + tid, NGT = (size_t)G * NWAVES * 64;
        for (int l = 0; l < DEPTH; ++l) {
            GAS v4u* z = (GAS v4u*)(ws + WS_WIN + l * SZ_WIN + (size_t)NIN * DM * 2);
            for (size_t i = gt; i < (size_t)(NINP - NIN) * DM * 2 / 16; i += NGT) z[i] = (v4u){0u, 0u, 0u, 0u};
        }
        { const GAS f32x4* xs = (const GAS f32x4*)args.in[0]; GAS v4u* xd = (GAS v4u*)XBF;
          for (size_t i = gt; i < (size_t)M * DM / 8; i += NGT) { const f32x4 a = xs[2 * i], b = xs[2 * i + 1]; xd[i] = (v4u){pk2(a.x, a.y), pk2(a.z, a.w), pk2(b.x, b.y), pk2(b.z, b.w)}; } }
        for (size_t i = gt; i < (size_t)4096 * 32; i += NGT) { float c, s; sincos_tab((int)(i >> 5), (int)(i & 31), c, s); ((float*)cosT)[i] = c; ((float*)sinT)[i] = s; }
    }
    SEAM(0);

    run_layer<0>(args, lds, bar, lo, hi, G, bx, wave, lane);
    run_layer<1>(args, lds, bar, lo, hi, G, bx, wave, lane);
#undef IN
#undef SEAM
}

extern "C" void kernel_launch(void* const* d_in, const int* in_sizes, int n_in, void* d_out, int out_size, void* d_ws, size_t ws_size, hipStream_t stream) {
    static int grid = 0;
    if (grid == 0) {
        if (n_in != 19 || in_sizes[0] != M * DM || out_size != M * DM || ws_size < WS_END) { fprintf(stderr, "kernel_launch: shape mismatch: n_in %d in0 %d out %d ws %zu (need %zu)\n", n_in, n_in > 0 ? in_sizes[0] : -1, out_size, ws_size, (size_t)WS_END); grid = -1; return; }
        int dev = 0, cus = 0, per_cu = 0;
        if (hipGetDevice(&dev) != hipSuccess || hipDeviceGetAttribute(&cus, hipDeviceAttributeMultiprocessorCount, dev) != hipSuccess) { fprintf(stderr, "kernel_launch: device query failed\n"); grid = -1; return; }
        if (hipFuncSetAttribute((const void*)mk_fwd, hipFuncAttributeMaxDynamicSharedMemorySize, LDS_BYTES) != hipSuccess) { fprintf(stderr, "kernel_launch: hipFuncSetAttribute failed\n"); grid = -1; return; }
        if (hipOccupancyMaxActiveBlocksPerMultiprocessor(&per_cu, (const void*)mk_fwd, NWAVES * 64, LDS_BYTES) != hipSuccess || per_cu < 1) fprintf(stderr, "kernel_launch: note: occupancy query reports %d workgroups per CU\n", per_cu);
        (void)hipGetLastError();
        grid = cus;
    }
    if (grid < 0) return;
    if (hipMemsetAsync((char*)d_ws + WS_CTL, 0, CTL_ZERO_BYTES, stream) != hipSuccess) { fprintf(stderr, "kernel_launch: memset failed\n"); return; }
    Args a{};
    for (int i = 0; i < 19; ++i) a.in[i] = (const float*)d_in[i];
    a.out = (float*)d_out; a.ws = (unsigned char*)d_ws;
#if MK_ONE_LAUNCH
    a.ph_lo = 0; a.ph_hi = N_PHASES;
    hipLaunchKernelGGL(mk_fwd, dim3(grid), dim3(NWAVES * 64), LDS_BYTES, stream, a);
#else
    for (int p = 0; p < N_PHASES; ++p) { a.ph_lo = p; a.ph_hi = p + 1; hipLaunchKernelGGL(mk_fwd, dim3(grid), dim3(NWAVES * 64), LDS_BYTES, stream, a); }
#endif
    const hipError_t le = hipPeekAtLastError();
    if (le != hipSuccess) fprintf(stderr, "kernel_launch: launch failed: %s\n", hipGetErrorName(le));
}
```
